# Optimizing an MI355X kernel written in HIP

```python
import jax
import jax.numpy as jnp
from jax import lax

D_MODEL = 2048
BATCH = 2
SEQ = 4096
DEPTH = 4
DEC_BATCH = 32
DEC_SEQ = 4
PAST_LEN = 16384
PAGE_SIZE = 128

N_META = 16
N_A_LAYERS = DEPTH // 2
N_B_LAYERS = DEPTH - N_A_LAYERS
GLA_HEADS = 4
GLA_KEY_DIM = D_MODEL // 2
GLA_VAL_DIM = D_MODEL
GLA_DK = GLA_KEY_DIM // GLA_HEADS
GLA_DV = GLA_VAL_DIM // GLA_HEADS
GATE_RANK = 16
GATE_LOGIT_NORM = 16.0
GLA_CHUNK = 64
GLA_IN_WIDTH = 2 * GLA_KEY_DIM + 2 * GLA_VAL_DIM + GATE_RANK
HEAD_DIM = 64
N_Q_HEADS = D_MODEL // HEAD_DIM
N_KV_HEADS = 8
GROUP = N_Q_HEADS // N_KV_HEADS
Q_WIDTH = N_Q_HEADS * HEAD_DIM
KV_WIDTH = N_KV_HEADS * HEAD_DIM
WINDOW = 128
BLOCK = 128
RMS_EPS = 1e-6
NEG_INF = -1e30

kernel_name = 'yoco_gla_swa_sink_step'


def rmsnorm(x, g):
    xf = x.astype(jnp.float32)
    y = xf * lax.rsqrt(jnp.mean(xf * xf, axis=-1, keepdims=True) + RMS_EPS)
    return (y * g.astype(jnp.float32)).astype(x.dtype)


def gla_recurrence(q, k, v, g, s0, chunk):
    B, L, H, _ = q.shape
    DV = v.shape[-1]
    pad = (-L) % chunk
    if pad:
        widths = ((0, 0), (pad, 0), (0, 0), (0, 0))
        q, k, v, g = (jnp.pad(t, widths) for t in (q, k, v, g))
    n = (L + pad) // chunk

    def to_chunks(t):
        return t.reshape(B, n, chunk, H, t.shape[-1]).transpose(1, 0, 3, 2, 4)

    tri = jnp.tril(jnp.ones((chunk, chunk), dtype=bool))

    def step(S, inp):
        qc, kc, vc, gc = inp
        b = jnp.cumsum(gc, axis=2)
        diff = b[:, :, :, None, :] - b[:, :, None, :, :]
        decay = jnp.where(tri[:, :, None], jnp.exp(jnp.minimum(diff, 0.0)), 0.0)
        att = jnp.einsum('bhid,bhjd,bhijd->bhij', qc, kc, decay)
        o = (jnp.einsum('bhij,bhjv->bhiv', att, vc)
             + jnp.einsum('bhid,bhdv->bhiv', qc * jnp.exp(b), S))
        b_last = b[:, :, -1:, :]
        S_new = (S * jnp.exp(b_last[:, :, 0, :])[..., None]
                 + jnp.einsum('bhjd,bhjv->bhdv', kc * jnp.exp(b_last - b), vc))
        return S_new.astype(S.dtype), o.astype(vc.dtype)

    S_fin, o = lax.scan(step, s0, (to_chunks(q), to_chunks(k), to_chunks(v), to_chunks(g)))
    o = o.transpose(1, 0, 3, 2, 4).reshape(B, L + pad, H, DV)[:, pad:]
    return o, S_fin


def gla_layer(x, s0, norm_w, w_in, w_gk2, b_gk2, onorm, w_out, chunk):
    B, L, _ = x.shape
    h = rmsnorm(x, norm_w)
    proj = h @ w_in
    q, k, v, gate, glr = jnp.split(
        proj, [GLA_KEY_DIM, 2 * GLA_KEY_DIM, 2 * GLA_KEY_DIM + GLA_VAL_DIM,
               2 * GLA_KEY_DIM + 2 * GLA_VAL_DIM], axis=-1)
    g = (jax.nn.log_sigmoid((glr @ w_gk2 + b_gk2).astype(jnp.float32))
         / GATE_LOGIT_NORM).astype(x.dtype)
    q = q.reshape(B, L, GLA_HEADS, GLA_DK) * (GLA_DK ** -0.5)
    k = k.reshape(B, L, GLA_HEADS, GLA_DK)
    v = v.reshape(B, L, GLA_HEADS, GLA_DV)
    g = g.reshape(B, L, GLA_HEADS, GLA_DK)
    o, S = gla_recurrence(q, k, v, g, s0, chunk)
    o = rmsnorm(o, onorm).reshape(B, L, GLA_VAL_DIM) * jax.nn.silu(gate)
    return x + o @ w_out, S


def shared_kv(x, norm_kv, w_kv):
    B, L, _ = x.shape
    kv = rmsnorm(x, norm_kv) @ w_kv
    k, v = jnp.split(kv, [KV_WIDTH], axis=-1)
    return (k.reshape(B, L, N_KV_HEADS, HEAD_DIM), v.reshape(B, L, N_KV_HEADS, HEAD_DIM))


def window_mask(qpos, kpos):
    return (kpos >= 0) & (kpos <= qpos) & (qpos - kpos < WINDOW)


def sink_softmax(s, sinks):
    col = jnp.broadcast_to(
        sinks.reshape(N_KV_HEADS, GROUP, 1).astype(jnp.float32), s.shape[:-1])[..., None]
    return jax.nn.softmax(jnp.concatenate([s, col], axis=-1), axis=-1)[..., :-1]


def swa_banded(q, k, v, sinks):
    B, L = q.shape[:2]
    pad = (-L) % BLOCK
    widths = ((0, 0), (pad, 0), (0, 0), (0, 0))
    q, k, v = (jnp.pad(t, widths) for t in (q, k, v))
    Lp = L + pad
    nb = Lp // BLOCK
    qb = q.reshape(B, nb, BLOCK, N_KV_HEADS, GROUP, HEAD_DIM)
    kb = k.reshape(B, nb, BLOCK, N_KV_HEADS, HEAD_DIM)
    vb = v.reshape(B, nb, BLOCK, N_KV_HEADS, HEAD_DIM)

    def with_prev(t):
        prev = jnp.concatenate([jnp.zeros_like(t[:, :1]), t[:, :-1]], axis=1)
        return jnp.concatenate([prev, t], axis=2)

    kc, vc = with_prev(kb), with_prev(vb)
    pos = jnp.arange(Lp, dtype=jnp.int32).reshape(nb, BLOCK) - pad
    kpos = jnp.concatenate([pos - BLOCK, pos], axis=1)
    mask = window_mask(pos[:, :, None], kpos[:, None, :])
    s = jnp.einsum('bnqhgd,bnkhd->bnhgqk', qb, kc).astype(jnp.float32) * (HEAD_DIM ** -0.5)
    s = jnp.where(mask[None, :, None, None], s, NEG_INF)
    p = sink_softmax(s, sinks).astype(v.dtype)
    o = jnp.einsum('bnhgqk,bnkhd->bnqhgd', p, vc)
    return o.reshape(B, Lp, N_Q_HEADS, HEAD_DIM)[:, pad:]


def swa_decode(q, k_all, v_all, sinks):
    Bd, T = q.shape[:2]
    Wc = k_all.shape[1] - T
    qg = q.reshape(Bd, T, N_KV_HEADS, GROUP, HEAD_DIM)
    qpos = PAST_LEN + jnp.arange(T, dtype=jnp.int32)
    kpos = jnp.concatenate([PAST_LEN - Wc + jnp.arange(Wc, dtype=jnp.int32), qpos])
    mask = window_mask(qpos[:, None], kpos[None, :])
    s = jnp.einsum('bqhgd,bkhd->bhgqk', qg, k_all).astype(jnp.float32) * (HEAD_DIM ** -0.5)
    s = jnp.where(mask, s, NEG_INF)
    p = sink_softmax(s, sinks).astype(v_all.dtype)
    o = jnp.einsum('bhgqk,bkhd->bqhgd', p, v_all)
    return o.reshape(Bd, T, N_Q_HEADS, HEAD_DIM)


def swa_layer(x, k, v, norm_w, w_in, sinks, w_out, attend):
    B, L, _ = x.shape
    h = rmsnorm(x, norm_w)
    q, gate = jnp.split(h @ w_in, [Q_WIDTH], axis=-1)
    o = attend(q.reshape(B, L, N_Q_HEADS, HEAD_DIM), k, v, sinks).reshape(B, L, Q_WIDTH)
    return x + (o * jax.nn.silu(gate)) @ w_out


def trunk(x, gla_s0, gla_chunk, attend, norm_a, w_in_a, w_gk2_a, b_gk2_a, onorm_a,
          w_out_a, norm_kv, w_kv, norm_b, w_in_b, sinks_b, w_out_b, norm_f):
    finals = []
    k_sh = None
    v_sh = None
    for layer in range(DEPTH):
        if layer < N_A_LAYERS:
            i = layer
            x, s = gla_layer(x, gla_s0[i], norm_a[i], w_in_a[i], w_gk2_a[i], b_gk2_a[i],
                             onorm_a[i], w_out_a[i], gla_chunk)
            finals.append(s)
            if layer == N_A_LAYERS - 1:
                k_sh, v_sh = shared_kv(x, norm_kv, w_kv)
        else:
            j = layer - N_A_LAYERS
            x = swa_layer(x, k_sh, v_sh, norm_b[j], w_in_b[j], sinks_b[j], w_out_b[j], attend)
    return rmsnorm(x, norm_f), jnp.stack(finals), k_sh, v_sh


def setup_inputs(seed: int = 0) -> dict:
    key = jax.random.key(seed)
    ks = jax.random.split(key, 20)

    def nrm(k, shape, scale):
        return jax.random.normal(k, shape, jnp.float32) * scale

    win = min(WINDOW, PAST_LEN)
    return {
        'x_prompt': nrm(ks[0], (BATCH, SEQ, D_MODEL), 1.0),
        'x_sample': nrm(ks[1], (DEC_BATCH, DEC_SEQ, D_MODEL), 1.0),
        'state_gla': nrm(ks[2], (N_A_LAYERS, DEC_BATCH, GLA_HEADS, GLA_DK, GLA_DV), 1.0),
        'cache_k_win': nrm(ks[3], (DEC_BATCH, win, N_KV_HEADS, HEAD_DIM), 1.0),
        'cache_v_win': nrm(ks[4], (DEC_BATCH, win, N_KV_HEADS, HEAD_DIM), 1.0),
        'meta_tokens': nrm(ks[5], (N_META, D_MODEL), 1.0),
        'norm_a': 1.0 + nrm(ks[6], (N_A_LAYERS, D_MODEL), 0.02),
        'w_in_a': nrm(ks[7], (N_A_LAYERS, D_MODEL, GLA_IN_WIDTH), D_MODEL ** -0.5),
        'w_gk2_a': nrm(ks[8], (N_A_LAYERS, GATE_RANK, GLA_KEY_DIM), GATE_RANK ** -0.5),
        'b_gk2_a': nrm(ks[9], (N_A_LAYERS, GLA_KEY_DIM), 0.02),
        'onorm_a': 1.0 + nrm(ks[10], (N_A_LAYERS, GLA_DV), 0.02),
        'w_out_a': nrm(ks[11], (N_A_LAYERS, GLA_VAL_DIM, D_MODEL), GLA_VAL_DIM ** -0.5),
        'norm_kv': 1.0 + nrm(ks[12], (D_MODEL,), 0.02),
        'w_kv': nrm(ks[13], (D_MODEL, 2 * KV_WIDTH), D_MODEL ** -0.5),
        'norm_b': 1.0 + nrm(ks[14], (N_B_LAYERS, D_MODEL), 0.02),
        'w_in_b': nrm(ks[15], (N_B_LAYERS, D_MODEL, 2 * Q_WIDTH), D_MODEL ** -0.5),
        'sinks_b': nrm(ks[16], (N_B_LAYERS, N_Q_HEADS), 1.0),
        'w_out_b': nrm(ks[17], (N_B_LAYERS, Q_WIDTH, D_MODEL), Q_WIDTH ** -0.5),
        'norm_f': 1.0 + nrm(ks[18], (D_MODEL,), 0.02),
    }


def reference(x_prompt, x_sample, state_gla, cache_k_win, cache_v_win, meta_tokens,
              norm_a, w_in_a, w_gk2_a, b_gk2_a, onorm_a, w_out_a, norm_kv, w_kv,
              norm_b, w_in_b, sinks_b, w_out_b, norm_f):
    win = cache_k_win.shape[1]
    B = x_prompt.shape[0]
    meta = jnp.broadcast_to(meta_tokens[None].astype(x_prompt.dtype), (B, N_META, D_MODEL))
    xp = jnp.concatenate([meta, x_prompt], axis=1)
    s0_p = jnp.zeros((N_A_LAYERS, B, GLA_HEADS, GLA_DK, GLA_DV), x_prompt.dtype)
    yp, sgla_p, k_p, v_p = trunk(
        xp, s0_p, GLA_CHUNK, swa_banded, norm_a, w_in_a, w_gk2_a, b_gk2_a, onorm_a,
        w_out_a, norm_kv, w_kv, norm_b, w_in_b, sinks_b, w_out_b, norm_f)
    y_prompt = yp[:, N_META:]
    k_win_p = k_p[:, -win:]
    v_win_p = v_p[:, -win:]

    def attend_sample(q, k, v, sinks):
        return swa_decode(q, jnp.concatenate([cache_k_win, k], axis=1),
                          jnp.concatenate([cache_v_win, v], axis=1), sinks)

    y_sample, sgla_s, k_s, v_s = trunk(
        x_sample, state_gla, x_sample.shape[1], attend_sample, norm_a, w_in_a, w_gk2_a,
        b_gk2_a, onorm_a, w_out_a, norm_kv, w_kv, norm_b, w_in_b, sinks_b, w_out_b, norm_f)
    k_win_s = jnp.concatenate([cache_k_win, k_s], axis=1)[:, -win:]
    v_win_s = jnp.concatenate([cache_v_win, v_s], axis=1)[:, -win:]
    return (y_prompt, y_sample, sgla_p, sgla_s, k_win_p, v_win_p, k_win_s, v_win_s)
```

```cpp
#include <hip/hip_runtime.h>
#include <hip/hip_cooperative_groups.h>
#include <cstdio>
#include <cstdint>
namespace cg = cooperative_groups;
namespace pg8 {
#define PG8_LAS __attribute__((address_space(3)))
typedef unsigned short bf16_t;
typedef short bf16x8 __attribute__((ext_vector_type(8)));
typedef float f32x4 __attribute__((ext_vector_type(4)));
typedef unsigned u32x4 __attribute__((ext_vector_type(4)));
constexpr int BM = 256, BK = 64, HALF = 128, HTB = HALF * BK * 2  , STAGE_BYTES = 8 * HTB, NXCD = 8, WGM = 8;

__host__ __device__ __forceinline__ int lds_byte(int r, int c) { const int st = (r >> 4) * 2 + (c >> 5), rr = r & 15, cc = c & 31, ob = rr * 64 + cc * 2; return st * 1024 + (ob ^ (((ob >> 9) & 1) << 5)); }
__host__ __device__ __forceinline__ void stage_rc(int b, int& R, int& C) { const int st = b / 1024, sb = b % 1024, swz = sb ^ (((sb >> 9) & 1) << 5); R = (st >> 1) * 16 + swz / 64; C = (st & 1) * 32 + (swz % 64) / 2; }
__host__ __device__ __forceinline__ int perm32(int rho) { const int n = rho >> 4, i = rho & 15; return 8 * (i >> 2) + 4 * n + (i & 3); }

struct Unit { int pm, pn; };
struct Gemm { const bf16_t* A; const bf16_t* Bt; int M, N, K; };

struct StaticOrder {
    int nM, nN, nwg, G, c;
    __host__ __device__ void init(int M, int N, int G_, int c_) { nM = M / BM; nN = N / BM; nwg = nM * nN; G = G_; c = c_; }
    __host__ __device__ bool next(int i, Unit& u) const {
        const long L = (long)i * G + c; if (L >= nwg) return false;
        int wgid = (int)L; { const int q = nwg / NXCD, r = nwg % NXCD, xcd = wgid % NXCD, off = wgid / NXCD; wgid = (xcd < r ? xcd * (q + 1) : r * (q + 1) + (xcd - r) * q) + off; }
        const int nig = WGM * nN, gid = wgid / nig, fm = gid * WGM, gsz = (nM - fm) < WGM ? (nM - fm) : WGM;
        u.pm = fm + ((wgid % nig) % gsz); u.pn = (wgid % nig) / gsz; return true;
    }
    __device__ __forceinline__ void a_ready(const Unit&) const {}
    __device__ __forceinline__ void done(const Unit&) const {}
};
__device__ __forceinline__ unsigned cvt_pk_bf16(float lo, float hi) { unsigned r; asm volatile("v_cvt_pk_bf16_f32 %0, %1, %2" : "=v"(r) : "v"(lo), "v"(hi)); return r; }
template <class Epi, class Sched, bool ALIGN_EPI = false, bool SP2 = false>
__device__ __forceinline__ void gemm_phase(PG8_LAS unsigned char* lds, const Gemm g, const Sched& S, const Epi& E) {
    int tid_l = threadIdx.x; asm volatile("" : "+v"(tid_l)); const int tid = tid_l, wid = __builtin_amdgcn_readfirstlane(tid >> 6), lane = tid & 63, wr = wid >> 2, wc = wid & 3, fr = lane & 15, fq = lane >> 4;
    const int K = g.K, nt = K / BK;
    unsigned voffA[2], voffB[2];
#pragma unroll
    for (int i = 0; i < 2; ++i) { int R, C; stage_rc(tid * 16 + i * 8192, R, C); const int Rb = Epi::PERM ? ((R & ~31) + perm32(R & 31)) : R;
        voffA[i] = (unsigned)(R * K + C) * 2u; voffB[i] = (unsigned)(Rb * K + C) * 2u; }
    const size_t kstep = (size_t)(BK * 2);
    const size_t hstep = (size_t)HALF * K * 2;
    const size_t tstep = 2 * hstep;
    const unsigned ldsw = (unsigned)wid * 1024u;
    const int aoff = lds_byte(wr * 64 + fr, fq * 8), boff = lds_byte(wc * 32 + fr, fq * 8);
#define PG8_SA(b, h) (((b) * 2 + (h)) * HTB)
#define PG8_SB(b, h) ((4 + (b) * 2 + (h)) * HTB)
#define PG8_STAGE(bufoff, gbase, voff) do { _Pragma("unroll") for (int _i = 0; _i < 2; ++_i) \
        __builtin_amdgcn_global_load_lds((const unsigned*)((const char*)(gbase) + (voff)[_i]), (PG8_LAS unsigned*)(lds + (bufoff) + ldsw + _i * 8192), 16, 0, 0); } while (0)
#define PG8_LDA(dst, b, h) do { _Pragma("unroll") for (int m = 0; m < 4; ++m) _Pragma("unroll") for (int k = 0; k < 2; ++k) dst[m][k] = *(const PG8_LAS bf16x8*)(lds + PG8_SA(b, h) + aoff + m * 2048 + k * 1024); } while (0)
#define PG8_LDB(dst, b, h) do { _Pragma("unroll") for (int n = 0; n < 2; ++n) _Pragma("unroll") for (int k = 0; k < 2; ++k) dst[n][k] = *(const PG8_LAS bf16x8*)(lds + PG8_SB(b, h) + boff + n * 2048 + k * 1024); } while (0)
#define PG8_MMA(ai, bj, At, Bt) do { __builtin_amdgcn_s_setprio(1); _Pragma("unroll") for (int m = 0; m < 4; ++m) _Pragma("unroll") for (int n = 0; n < 2; ++n) _Pragma("unroll") for (int k = 0; k < 2; ++k) \
        acc[ai][bj][m][n] = __builtin_amdgcn_mfma_f32_16x16x32_bf16(Bt[n][k], At[m][k], acc[ai][bj][m][n], 0, 0, 0); __builtin_amdgcn_s_setprio(0); } while (0)
#define PG8_WAIT_V(n) asm volatile("s_waitcnt vmcnt(" #n ")" ::: "memory")
#define PG8_WAIT_L(n) asm volatile("s_waitcnt lgkmcnt(" #n ")" ::: "memory")
#define PG8_BAR __builtin_amdgcn_s_barrier()
#define PG8_SCHED __builtin_amdgcn_sched_barrier(0)
    Unit cur, nxt; int ui = 0;
    if (!S.next(0, cur)) return;
    f32x4 acc[2][2][4][2];
#pragma unroll
    for (int a = 0; a < 2; ++a)
#pragma unroll
        for (int b = 0; b < 2; ++b)
#pragma unroll
            for (int m = 0; m < 4; ++m)
#pragma unroll
                for (int n = 0; n < 2; ++n) acc[a][b][m][n] = (f32x4){0.f, 0.f, 0.f, 0.f};
    bf16x8 At[4][2], B0[2][2], B1[2][2];
    const char* cA = (const char*)g.A + (size_t)cur.pm * tstep; const char* cB = (const char*)g.Bt + (size_t)cur.pn * tstep;
    S.a_ready(cur);
    if constexpr (SP2) {
        PG8_STAGE(PG8_SB(0, 0), cB, voffB); PG8_STAGE(PG8_SB(0, 1), cB + hstep, voffB); PG8_STAGE(PG8_SA(0, 0), cA, voffA); PG8_STAGE(PG8_SA(0, 1), cA + hstep, voffA);
        if (wr == 1) PG8_BAR;
        PG8_WAIT_V(2); PG8_BAR;
        PG8_STAGE(PG8_SB(1, 0), cB + kstep, voffB); PG8_STAGE(PG8_SA(1, 0), cA + kstep, voffA); PG8_STAGE(PG8_SB(1, 1), cB + hstep + kstep, voffB);
        PG8_WAIT_V(6); PG8_BAR;
    } else {
        PG8_STAGE(PG8_SB(0, 0), cB, voffB); PG8_STAGE(PG8_SA(0, 0), cA, voffA); PG8_STAGE(PG8_SB(0, 1), cB + hstep, voffB); PG8_STAGE(PG8_SA(0, 1), cA + hstep, voffA);
        if (wr == 1) PG8_BAR;
        PG8_WAIT_V(4); PG8_BAR;
        PG8_STAGE(PG8_SB(1, 0), cB + kstep, voffB); PG8_STAGE(PG8_SA(1, 0), cA + kstep, voffA); PG8_STAGE(PG8_SB(1, 1), cB + hstep + kstep, voffB);
        PG8_WAIT_V(6); PG8_BAR;
    }
    for (;;) {
        const bool has_next = S.next(ui + 1, nxt);
        const char* nA = has_next ? (const char*)g.A + (size_t)nxt.pm * tstep : cA; const char* nB = has_next ? (const char*)g.Bt + (size_t)nxt.pn * tstep : cB;
        for (int t = 0; t < nt; t += 2) {
            const bool last = (t == nt - 2);
            const char* a1 = cA + (size_t)(t + 1) * kstep;
            const char* a2 = last ? nA : cA + (size_t)(t + 2) * kstep; const char* b2 = last ? nB : cB + (size_t)(t + 2) * kstep;
            const char* a3 = a2 + kstep; const char* b3 = b2 + kstep;
            if (last && has_next) S.a_ready(nxt);
            if constexpr (SP2) {
            PG8_LDB(B0, 0, 0); PG8_LDB(B1, 0, 1); PG8_SCHED; PG8_LDA(At, 0, 0); PG8_STAGE(PG8_SA(1, 1), a1 + hstep, voffA);
            PG8_WAIT_V(8); PG8_WAIT_L(0); PG8_BAR; PG8_MMA(0, 0, At, B0); PG8_MMA(0, 1, At, B1); PG8_BAR; PG8_SCHED;
            PG8_LDA(At, 0, 1); PG8_STAGE(PG8_SB(0, 0), b2, voffB); PG8_STAGE(PG8_SB(0, 1), b2 + hstep, voffB); PG8_STAGE(PG8_SA(0, 0), a2, voffA);
            PG8_WAIT_V(8); PG8_WAIT_L(0); PG8_BAR; PG8_MMA(1, 0, At, B0); PG8_MMA(1, 1, At, B1); PG8_BAR; PG8_SCHED;
            PG8_LDB(B0, 1, 0); PG8_LDB(B1, 1, 1); PG8_SCHED; PG8_LDA(At, 1, 0); PG8_STAGE(PG8_SA(0, 1), a2 + hstep, voffA);
            PG8_WAIT_V(8); PG8_WAIT_L(0); PG8_BAR; PG8_MMA(0, 0, At, B0); PG8_MMA(0, 1, At, B1); PG8_BAR; PG8_SCHED;
            PG8_LDA(At, 1, 1); PG8_STAGE(PG8_SB(1, 0), b3, voffB); PG8_STAGE(PG8_SB(1, 1), b3 + hstep, voffB); PG8_STAGE(PG8_SA(1, 0), a3, voffA);
            PG8_WAIT_V(8); PG8_WAIT_L(0); PG8_BAR; PG8_MMA(1, 0, At, B0); PG8_MMA(1, 1, At, B1); PG8_BAR; PG8_SCHED;
            } else {
            PG8_LDB(B0, 0, 0); PG8_SCHED; PG8_LDA(At, 0, 0); PG8_STAGE(PG8_SA(1, 1), a1 + hstep, voffA);
            PG8_WAIT_L(8); PG8_BAR; PG8_WAIT_L(0); PG8_MMA(0, 0, At, B0); PG8_BAR; PG8_SCHED;
            PG8_LDB(B1, 0, 1); PG8_STAGE(PG8_SB(0, 0), b2, voffB);
            PG8_BAR; PG8_WAIT_L(0); PG8_MMA(0, 1, At, B1); PG8_BAR;
            PG8_LDA(At, 0, 1); PG8_STAGE(PG8_SA(0, 0), a2, voffA);
            PG8_BAR; PG8_WAIT_L(0); PG8_MMA(1, 0, At, B0); PG8_BAR; PG8_SCHED;
            PG8_STAGE(PG8_SB(0, 1), b2 + hstep, voffB);
            PG8_WAIT_V(6); PG8_BAR; PG8_MMA(1, 1, At, B1); PG8_BAR;
            PG8_LDB(B0, 1, 0); PG8_SCHED; PG8_LDA(At, 1, 0); PG8_STAGE(PG8_SA(0, 1), a2 + hstep, voffA);
            PG8_WAIT_L(8); PG8_BAR; PG8_WAIT_L(0); PG8_MMA(0, 0, At, B0); PG8_BAR; PG8_SCHED;
            PG8_LDB(B1, 1, 1); PG8_STAGE(PG8_SB(1, 0), b3, voffB);
            PG8_BAR; PG8_WAIT_L(0); PG8_MMA(0, 1, At, B1); PG8_BAR;
            PG8_LDA(At, 1, 1); PG8_STAGE(PG8_SA(1, 0), a3, voffA);
            PG8_BAR; PG8_WAIT_L(0); PG8_MMA(1, 0, At, B0); PG8_BAR; PG8_SCHED;
            PG8_STAGE(PG8_SB(1, 1), b3 + hstep, voffB);
            PG8_WAIT_V(6); PG8_BAR; PG8_MMA(1, 1, At, B1); PG8_BAR;
            }
        }
        if constexpr (ALIGN_EPI) { if (wr == 0) PG8_BAR; }
        if constexpr (!Epi::AFTER_DRAIN) { E(acc, cur, wr, wc, fr, fq); S.done(cur); }
        if (!has_next) break;
#pragma unroll
        for (int a = 0; a < 2; ++a)
#pragma unroll
            for (int b = 0; b < 2; ++b)
#pragma unroll
                for (int m = 0; m < 4; ++m)
#pragma unroll
                    for (int n = 0; n < 2; ++n) acc[a][b][m][n] = (f32x4){0.f, 0.f, 0.f, 0.f};
        cur = nxt; cA = nA; cB = nB; ++ui;
        if constexpr (ALIGN_EPI) { if (wr == 1) PG8_BAR; }
    }
    PG8_WAIT_V(0);
    if constexpr (!ALIGN_EPI) { if (wr == 0) PG8_BAR; }
    PG8_BAR;
    if constexpr (Epi::AFTER_DRAIN) { E.fused(acc, cur, wr, wc, fr, fq, lds, wid, lane); S.done(cur); }
#undef PG8_SA
#undef PG8_SB
#undef PG8_STAGE
#undef PG8_LDA
#undef PG8_LDB
#undef PG8_MMA
#undef PG8_WAIT_V
#undef PG8_WAIT_L
#undef PG8_BAR
#undef PG8_SCHED
}
}
#define LAS __attribute__((address_space(3)))
typedef unsigned short bf16_t;
typedef short bf16x8 __attribute__((ext_vector_type(8)));
typedef short s16x4 __attribute__((ext_vector_type(4)));
typedef float f32x4 __attribute__((ext_vector_type(4)));
typedef unsigned u32x4 __attribute__((ext_vector_type(4)));
typedef unsigned u32x2 __attribute__((ext_vector_type(2)));

constexpr int DM = 2048, MP = 8448, ROW_META = 8192, ROW_SAMP = 8208, ROW_END = 8336;
constexpr int NA_IN = 6160, NA_PAD = 6400;
constexpr float EPS = 1e-6f;
constexpr size_t WS_WTA_IN = 0, WTA_IN_SZ = (size_t)NA_PAD * DM * 2;
constexpr size_t WS_WTA_OUT = WS_WTA_IN + 2 * WTA_IN_SZ, WT_SQ_SZ = (size_t)DM * DM * 2;
constexpr size_t WS_WTB0 = WS_WTA_OUT + 2 * WT_SQ_SZ;
constexpr size_t WS_WTB1 = WS_WTB0 + (size_t)5120 * DM * 2;
constexpr size_t WS_WTB_OUT = WS_WTB1 + (size_t)4096 * DM * 2;
constexpr size_t WS_X = WS_WTB_OUT + 2 * WT_SQ_SZ;
constexpr size_t WS_XB = WS_X + (size_t)MP * DM * 4;
constexpr size_t ACT_SZ = (size_t)MP * DM * 2;
constexpr size_t WS_R1 = WS_XB + ACT_SZ;
constexpr size_t WS_R2 = WS_R1 + ACT_SZ;
constexpr size_t WS_SG = WS_R2 + ACT_SZ;
constexpr size_t WS_OG = WS_SG + ACT_SZ;
constexpr size_t WS_SSQ = WS_OG + ACT_SZ;
constexpr size_t WS_GLR = WS_SSQ + (size_t)MP * 32 * 4;
constexpr size_t WS_DEC = WS_GLR + (size_t)MP * 16 * 4;
constexpr size_t WS_DSM = WS_DEC + (size_t)2 * 64 * 4 * 256 * 4;
constexpr size_t WS_ORAW = WS_DSM + (size_t)4 * 512 * 256 * 2;
constexpr size_t WS_DS = WS_ORAW + (size_t)32 * 4 * 4 * 512 * 4;
constexpr size_t WS_CTL = WS_DS + (size_t)2 * 64 * 4 * 512 * 256 * 2, CTL_BYTES = 65536;
constexpr size_t WS_END = WS_CTL + CTL_BYTES;
constexpr size_t O_YP = 0, O_YS = 16777216, O_SP = O_YS + 262144, O_SS = O_SP + 2097152, O_KWP = O_SS + 33554432,
                 O_VWP = O_KWP + 131072, O_KWS = O_VWP + 131072, O_VWS = O_KWS + 2097152;
constexpr int LDS_BYTES = 147456;
constexpr int NTHR = 512;

struct Params { const float* in[19]; float* out; unsigned char* ws; int ph_lo, ph_hi; };
enum { I_XP = 0, I_XS, I_SGLA, I_CK, I_CV, I_META, I_NORM_A, I_WIN_A, I_WGK2, I_BGK2, I_ONORM, I_WOUT_A, I_NORM_KV, I_WKV, I_NORM_B, I_WIN_B, I_SINKS, I_WOUT_B, I_NORM_F };

__device__ __forceinline__ unsigned f2bf(float f) { unsigned u = __builtin_bit_cast(unsigned, f); return (u + 0x7fffu + ((u >> 16) & 1u)) >> 16; }
typedef float f32x2_t __attribute__((ext_vector_type(2))); typedef __bf16 bf16x2_t __attribute__((ext_vector_type(2)));
__device__ __forceinline__ unsigned pk2(float lo, float hi) { const f32x2_t v = {lo, hi}; const bf16x2_t b = __builtin_convertvector(v, bf16x2_t); return __builtin_bit_cast(unsigned, b); }
__device__ __forceinline__ float bf2f(unsigned h) { return __builtin_bit_cast(float, h << 16); }
__device__ __forceinline__ float bflo(unsigned w) { return __builtin_bit_cast(float, w << 16); }
__device__ __forceinline__ float bfhi(unsigned w) { return __builtin_bit_cast(float, w & 0xffff0000u); }
__device__ __forceinline__ float wave_sum(float v) {
#pragma unroll
    for (int o = 1; o < 64; o <<= 1) v += __shfl_xor(v, o);
    return v;
}
__device__ __forceinline__ float wave_max(float v) {
#pragma unroll
    for (int o = 1; o < 64; o <<= 1) v = fmaxf(v, __shfl_xor(v, o));
    return v;
}
__device__ __forceinline__ float silu_f(float x) { return x / (1.0f + __expf(-x)); }
__device__ __forceinline__ s16x4 vtr(const LAS bf16_t* p) {
    typedef short v4i16_t __attribute__((ext_vector_type(4)));
    return __builtin_bit_cast(s16x4, __builtin_amdgcn_ds_read_tr16_b64_v4i16((LAS v4i16_t*)p));
}
__device__ __forceinline__ bf16x8 cat8(s16x4 a, s16x4 b) { return (bf16x8){a[0], a[1], a[2], a[3], b[0], b[1], b[2], b[3]}; }
#define MFMA16(a, b, c) __builtin_amdgcn_mfma_f32_16x16x32_bf16((a), (b), (c), 0, 0, 0)

namespace pg8 {
__device__ __forceinline__ float row_rinv(const float* ssq, int row) {
    const f32x4* p = (const f32x4*)(ssq + (size_t)row * 32); float s = 0.f;
#pragma unroll
    for (int i = 0; i < 8; ++i) { const f32x4 v = p[i]; s += (v[0] + v[1]) + (v[2] + v[3]); }
    return rsqrtf(s * (1.0f / DM) + EPS);
}
__device__ __forceinline__ u32x4 pack8(f32x4 a, f32x4 b) { u32x4 w; w.x = pk2(a[0], a[1]); w.y = pk2(a[2], a[3]); w.z = pk2(b[0], b[1]); w.w = pk2(b[2], b[3]); return w; }
__device__ __forceinline__ f32x4 silu4(f32x4 a) { return (f32x4){silu_f(a[0]), silu_f(a[1]), silu_f(a[2]), silu_f(a[3])}; }

struct EpiGlaIn {
    static constexpr bool PERM = true, AFTER_DRAIN = false;
    const float* ssq; bf16_t* Q; bf16_t* K; bf16_t* V; bf16_t* SG; float* GLR;
    __device__ __forceinline__ void store8(int row, int col, f32x4 v0, f32x4 v1) const {
        const int pn = col >> 8;
        if (pn < 4) *(u32x4*)(Q + (size_t)row * 1024 + col) = pack8(v0, v1);
        else if (pn < 8) *(u32x4*)(K + (size_t)row * 1024 + (col - 1024)) = pack8(v0, v1);
        else if (pn < 16) *(u32x4*)(V + (size_t)row * 2048 + (col - 2048)) = pack8(v0, v1);
        else if (pn < 24) *(u32x4*)(SG + (size_t)row * 2048 + (col - 4096)) = pack8(silu4(v0), silu4(v1));
        else if (col < NA_IN) { *(f32x4*)(GLR + (size_t)row * 16 + (col - 6144)) = v0; *(f32x4*)(GLR + (size_t)row * 16 + (col - 6144) + 4) = v1; }
    }
    __device__ __forceinline__ void operator()(const f32x4 (&acc)[2][2][4][2], const Unit& u, int wr, int wc, int fr, int fq) const {
        const int row0 = u.pm * BM + wr * 64 + fr; const int pn = u.pn;
#pragma unroll
        for (int ai = 0; ai < 2; ++ai)
#pragma unroll
            for (int m = 0; m < 4; ++m) {
                const int row = row0 + ai * HALF + m * 16; const float rs = row_rinv(ssq, row);
#pragma unroll
                for (int bj = 0; bj < 2; ++bj) store8(row, pn * BM + bj * HALF + wc * 32 + 8 * fq, acc[ai][bj][m][0] * rs, acc[ai][bj][m][1] * rs);
            }
    }
    __device__ __forceinline__ void tail16(int row, int col, f32x4 a0, f32x4 a1, f32x4 a2, f32x4 a3) const {
        const float rs = row_rinv(ssq, row); store8(row, col, a0 * rs, a1 * rs); store8(row, col + 8, a2 * rs, a3 * rs);
    }
};
struct EpiSwaIn {
    static constexpr bool PERM = true, AFTER_DRAIN = false;
    const float* ssq; bf16_t* KV; bf16_t* Q; bf16_t* SG; float* out; int kvt;
    __device__ __forceinline__ void store8(int row, int col, f32x4 v0, f32x4 v1) const {
        const int pn = col >> 8;
        if (pn < kvt) {
            *(u32x4*)(KV + (size_t)row * 1024 + col) = pack8(v0, v1);
            float* dst = nullptr; const int c5 = col & 511; const bool isv = col >= 512;
            if (row < ROW_META) { const int b = row >> 12, t = row & 4095; if (t >= 3968) dst = out + (isv ? O_VWP : O_KWP) + ((size_t)(b * 128 + t - 3968) * 512 + c5); }
            else if (row >= ROW_SAMP && row < ROW_END) { const int bs = (row - ROW_SAMP) >> 2, t = (row - ROW_SAMP) & 3; dst = out + (isv ? O_VWS : O_KWS) + ((size_t)(bs * 128 + 124 + t) * 512 + c5); }
            if (dst) { *(f32x4*)dst = v0; *(f32x4*)(dst + 4) = v1; }
        } else if (pn < kvt + 8) *(u32x4*)(Q + (size_t)row * 2048 + (col - kvt * 256)) = pack8(v0, v1);
        else *(u32x4*)(SG + (size_t)row * 2048 + (col - kvt * 256 - 2048)) = pack8(silu4(v0), silu4(v1));
    }
    __device__ __forceinline__ void operator()(const f32x4 (&acc)[2][2][4][2], const Unit& u, int wr, int wc, int fr, int fq) const {
        const int row0 = u.pm * BM + wr * 64 + fr; const int pn = u.pn;
#pragma unroll
        for (int ai = 0; ai < 2; ++ai)
#pragma unroll
            for (int m = 0; m < 4; ++m) {
                const int row = row0 + ai * HALF + m * 16; const float rs = row_rinv(ssq, row);
#pragma unroll
                for (int bj = 0; bj < 2; ++bj) store8(row, pn * BM + bj * HALF + wc * 32 + 8 * fq, acc[ai][bj][m][0] * rs, acc[ai][bj][m][1] * rs);
            }
    }
    __device__ __forceinline__ void tail16(int row, int col, f32x4 a0, f32x4 a1, f32x4 a2, f32x4 a3) const {
        const float rs = row_rinv(ssq, row); store8(row, col, a0 * rs, a1 * rs); store8(row, col + 8, a2 * rs, a3 * rs);
    }
};
struct EpiOut {
    static constexpr bool PERM = true, AFTER_DRAIN = false;
    float* X; bf16_t* XB; float* ssq;
    __device__ __forceinline__ float upd8(int row, int col, f32x4 a0, f32x4 a1) const {
        bf16_t* xp = XB + (size_t)row * DM + col; const u32x4 xo = *(const u32x4*)xp;
        const f32x4 v0 = (f32x4){bflo(xo.x), bfhi(xo.x), bflo(xo.y), bfhi(xo.y)} + a0, v1 = (f32x4){bflo(xo.z), bfhi(xo.z), bflo(xo.w), bfhi(xo.w)} + a1;
        const u32x4 w = pack8(v0, v1); *(u32x4*)xp = w;
        const f32x4 r0 = (f32x4){bflo(w.x), bfhi(w.x), bflo(w.y), bfhi(w.y)}, r1 = (f32x4){bflo(w.z), bfhi(w.z), bflo(w.w), bfhi(w.w)};
        return (r0[0] * r0[0] + r0[1] * r0[1]) + (r0[2] * r0[2] + r0[3] * r0[3]) + (r1[0] * r1[0] + r1[1] * r1[1]) + (r1[2] * r1[2] + r1[3] * r1[3]);
    }
    __device__ __forceinline__ void operator()(const f32x4 (&acc)[2][2][4][2], const Unit& u, int wr, int wc, int fr, int fq) const {
        const int row0 = u.pm * BM + wr * 64 + fr; const int pn = u.pn;
#pragma unroll
        for (int ai = 0; ai < 2; ++ai)
#pragma unroll
            for (int m = 0; m < 4; ++m) {
                const int row = row0 + ai * HALF + m * 16; float ss = 0.f;
#pragma unroll
                for (int bj = 0; bj < 2; ++bj) ss += upd8(row, pn * BM + bj * HALF + wc * 32 + 8 * fq, acc[ai][bj][m][0], acc[ai][bj][m][1]);
                ss += __shfl_xor(ss, 16); ss += __shfl_xor(ss, 32);
                if (fq == 0) ssq[(size_t)row * 32 + pn * 4 + wc] = ss;
            }
    }
    __device__ __forceinline__ void tail16(int row, int col, f32x4 a0, f32x4 a1, f32x4 a2, f32x4 a3) const {
        float ss = upd8(row, col, a0, a1) + upd8(row, col + 8, a2, a3);
        ss += __shfl_xor(ss, 16); ss += __shfl_xor(ss, 32);
        if ((threadIdx.x & 63) < 16) ssq[(size_t)row * 32 + (col >> 6)] = ss;
    }
};
}

__device__ __forceinline__ void transpose_item(const float* __restrict__ W, int K, int N, bf16_t* WT, int row_off, const float* __restrict__ gain, int qcols, float qscale,
                                               LAS float* scr, int item, int lane) {
    const int nblk = (N + 63) / 64, kb = item / nblk, nb = item % nblk, k0 = 64 * kb, n0 = 64 * nb;
    const int c4 = lane & 15, r = lane >> 4; const int nn = n0 + 4 * c4; const bool nv = nn < N;
    f32x4 v[16];
#pragma unroll
    for (int i = 0; i < 16; ++i) { const int kk = 4 * i + r; v[i] = nv ? __builtin_nontemporal_load((const f32x4*)(W + (size_t)(k0 + kk) * N + nn)) : (f32x4){0.f, 0.f, 0.f, 0.f}; }
#pragma unroll
    for (int i = 0; i < 16; ++i) { const int kk = 4 * i + r; const float gn = gain ? gain[k0 + kk] : 1.0f; LAS float* s = scr + kk * 65 + 4 * c4;
        s[0] = v[i][0] * gn; s[1] = v[i][1] * gn; s[2] = v[i][2] * gn; s[3] = v[i][3] * gn; }
    asm volatile("s_waitcnt lgkmcnt(0)" ::: "memory");
    const int c = lane & 7;
#pragma unroll
    for (int j = 0; j < 8; ++j) { const int n = (lane >> 3) + 8 * j; const LAS float* s = scr + (8 * c) * 65 + n;
        if (n0 + n < N) { const float cs = (n0 + n < qcols) ? qscale : 1.0f;
            u32x4 o; o.x = pk2(s[0 * 65] * cs, s[1 * 65] * cs); o.y = pk2(s[2 * 65] * cs, s[3 * 65] * cs); o.z = pk2(s[4 * 65] * cs, s[5 * 65] * cs); o.w = pk2(s[6 * 65] * cs, s[7 * 65] * cs);
            *(u32x4*)(WT + (size_t)(row_off + n0 + n) * K + k0 + 8 * c) = o; } }
    asm volatile("s_waitcnt lgkmcnt(0)" ::: "memory");
}

constexpr int CV_INA = 32 * 97, CV_SQ = 32 * 32, CV_KV = 32 * 16, CV_INB = 32 * 64;
constexpr int CV_NITEMS = 2 * CV_INA + 4 * CV_SQ + CV_KV + 2 * CV_INB;
constexpr int CV_OA = 2 * CV_INA, CV_OB0 = CV_OA + 2 * CV_SQ, CV_KVB = CV_OB0 + CV_SQ, CV_IB0 = CV_KVB + CV_KV, CV_IB1 = CV_IB0 + CV_INB, CV_OB1 = CV_IB1 + CV_INB;
static_assert(CV_OB1 + CV_SQ == CV_NITEMS, "item map");
__device__ __forceinline__ bool cv_moved(int it) { return it >= CV_INA; }
__device__ __forceinline__ void convert_any(const Params& p, int it, LAS float* scr, int lane) {
    unsigned char* ws = p.ws; int r = it;
    const float* W; int N; bf16_t* WT; int row_off = 0; const float* gain = nullptr; int qcols = 0; float qscale = 1.f;
    if (r < CV_OA) { const int l = r / CV_INA; r -= l * CV_INA; W = p.in[I_WIN_A] + (size_t)l * DM * NA_IN; N = NA_IN; WT = (bf16_t*)(ws + WS_WTA_IN + l * WTA_IN_SZ); gain = p.in[I_NORM_A] + l * DM; qcols = 1024; qscale = 0.0625f; }
    else if (r < CV_OB0) { r -= CV_OA; const int l = r / CV_SQ; r -= l * CV_SQ; W = p.in[I_WOUT_A] + (size_t)l * DM * DM; N = DM; WT = (bf16_t*)(ws + WS_WTA_OUT + l * WT_SQ_SZ); }
    else if (r < CV_KVB) { r -= CV_OB0; W = p.in[I_WOUT_B]; N = DM; WT = (bf16_t*)(ws + WS_WTB_OUT); }
    else if (r < CV_IB0) { r -= CV_KVB; W = p.in[I_WKV]; N = 1024; WT = (bf16_t*)(ws + WS_WTB0); gain = p.in[I_NORM_KV]; }
    else if (r < CV_IB1) { r -= CV_IB0; W = p.in[I_WIN_B]; N = 4096; WT = (bf16_t*)(ws + WS_WTB0); row_off = 1024; gain = p.in[I_NORM_B]; qcols = 2048; qscale = 0.125f; }
    else if (r < CV_OB1) { r -= CV_IB1; W = p.in[I_WIN_B] + (size_t)DM * 4096; N = 4096; WT = (bf16_t*)(ws + WS_WTB1); gain = p.in[I_NORM_B] + DM; qcols = 2048; qscale = 0.125f; }
    else { r -= CV_OB1; W = p.in[I_WOUT_B] + (size_t)DM * DM; N = DM; WT = (bf16_t*)(ws + WS_WTB_OUT + WT_SQ_SZ); }
    transpose_item(W, DM, N, WT, row_off, gain, qcols, qscale, scr, r, lane);
}
__device__ __forceinline__ void cache_copy(const Params& p, int gt, int NT) {
    constexpr int NC = 32 * 124 * 128;
    for (int i = gt; i < 2 * NC; i += NT) { const int kv = i / NC, r = i - kv * NC; const int bs = r / (124 * 128), r2 = r - bs * (124 * 128), j = r2 >> 7, c4 = r2 & 127;
        const f32x4 v = __builtin_nontemporal_load((const f32x4*)(p.in[kv ? I_CV : I_CK] + ((size_t)(bs * 128 + j + 4) * 512 + c4 * 4)));
        __builtin_nontemporal_store(v, (f32x4*)(p.out + (kv ? O_VWS : O_KWS) + ((size_t)(bs * 128 + j) * 512 + c4 * 4))); }
}
__device__ __forceinline__ void slot_convert(const Params& p, LAS unsigned char* lds, int it0, int n, int nidle, int lane, int wave, int bid) {
    if (nidle <= 0 || bid >= nidle) return;
    LAS float* scr = (LAS float*)(lds + wave * 16640);
    for (int k = bid * 8 + wave; k < n; k += nidle * 8) convert_any(p, it0 + k, scr, lane);
}

__device__ __forceinline__ void phase_p0(const Params& p, LAS unsigned char* lds, int tid, int lane, int wave, int bid, int G) {
    LAS float* scr = (LAS float*)(lds + wave * 16640);
    const int gw = bid * 8 + wave, NGW = G * 8;
    unsigned char* ws = p.ws;
    const bool moved_ok = G > 194;
    for (int it = gw; it < CV_NITEMS; it += NGW) { if (moved_ok && cv_moved(it)) continue; convert_any(p, it, scr, lane); }
    {
        const int gt = bid * NTHR + tid, NT = G * NTHR; constexpr int NZ = 240 * DM * 2 / 16;
        for (int i = gt; i < 2 * NZ; i += NT) { const int l = i / NZ, r = i - l * NZ;
            ((u32x4*)(ws + WS_WTA_IN + l * WTA_IN_SZ + (size_t)NA_IN * DM * 2))[r] = (u32x4){0u, 0u, 0u, 0u}; }
        if (!moved_ok) cache_copy(p, gt, NT);
    }
    bf16_t* XB = (bf16_t*)(ws + WS_XB); float* SSQ = (float*)(ws + WS_SSQ);
    for (int r = gw; r < MP; r += NGW) {
        const float* src = r < ROW_META ? p.in[I_XP] + (size_t)r * DM : r < ROW_SAMP ? p.in[I_META] + (size_t)(r - ROW_META) * DM : r < ROW_END ? p.in[I_XS] + (size_t)(r - ROW_SAMP) * DM : nullptr;
        f32x4 v[8]; float ss = 0.f;
#pragma unroll
        for (int j = 0; j < 8; ++j) v[j] = src ? __builtin_nontemporal_load((const f32x4*)src + lane + 64 * j) : (f32x4){0.f, 0.f, 0.f, 0.f};
#pragma unroll
        for (int j = 0; j < 8; ++j) { const unsigned w0 = pk2(v[j][0], v[j][1]), w1 = pk2(v[j][2], v[j][3]);
            ((u32x2*)(XB + (size_t)r * DM))[lane + 64 * j] = (u32x2){w0, w1};
            const float a0 = bflo(w0), a1 = bfhi(w0), a2 = bflo(w1), a3 = bfhi(w1); ss += (a0 * a0 + a1 * a1) + (a2 * a2 + a3 * a3); }
        ss = wave_sum(ss);
        if (lane < 32) SSQ[(size_t)r * 32 + lane] = lane == 0 ? ss : 0.f;
    }
}
constexpr int L_VS = 0, VS_P = 520;
constexpr int L_QT = 66560, QK_P = 264;
constexpr int L_KT = L_QT + 64 * QK_P * 2;
constexpr int L_KET = 66560, KET_P = 72;
constexpr int L_KRAW = L_KET + 256 * KET_P * 2;
constexpr int ATT_P = 72;
constexpr int L_GLR = 137216, L_HSUM = L_GLR + 4096, L_ROWSQ = L_HSUM + 2048;
static_assert(L_KRAW + 64 * QK_P * 2 <= L_GLR && L_KT + 64 * QK_P * 2 <= L_GLR && L_ROWSQ + 2048 <= LDS_BYTES - 16, "LDS map");

#define LDS_BAR() asm volatile("s_waitcnt lgkmcnt(0)\n\ts_barrier" ::: "memory")

__device__ __forceinline__ float gate_val(const LAS float* glr_row, const float (&w)[16], float bias) {
    float x = bias;
#pragma unroll
    for (int q4 = 0; q4 < 4; ++q4) { const f32x4 g = *(const LAS f32x4*)(glr_row + 4 * q4); x += g[0] * w[4 * q4] + g[1] * w[4 * q4 + 1] + g[2] * w[4 * q4 + 2] + g[3] * w[4 * q4 + 3]; }
    const float ls = fminf(x, 0.f) - __logf(1.0f + __expf(-fabsf(x)));
    return ls * 0.0625f;
}

template <int NC, int P>
__device__ __forceinline__ void stage_rows(LAS bf16_t* dst, int tid, const bf16_t* __restrict__ src, int ld, int row0, int ntok, int col0) {
#pragma unroll
    for (int i = 0; i < NC * 64 / NTHR; ++i) { const int chunk = tid + NTHR * i, j = chunk / NC, c = chunk % NC;
        u32x4 v = (u32x4){0u, 0u, 0u, 0u}; if (j < ntok) v = *(const u32x4*)(src + (size_t)(row0 + j) * ld + col0 + c * 8);
        *(LAS u32x4*)(dst + j * P + c * 8) = v; }
}
__device__ __forceinline__ void stage_glr(LAS unsigned char* lds, int tid, const float* __restrict__ GLR, int row0, int ntok) {
    if (tid < 256) { const int j = tid >> 2, r4 = tid & 3; f32x4 v = (f32x4){0.f, 0.f, 0.f, 0.f}; if (j < ntok) v = *(const f32x4*)(GLR + (size_t)(row0 + j) * 16 + r4 * 4); *(LAS f32x4*)((LAS float*)(lds + L_GLR) + j * 16 + r4 * 4) = v; }
}

template <int MODE>
__device__ __forceinline__ void gate_pass(LAS unsigned char* lds, int tid, int ntok, int h, const float* __restrict__ wg, const float* __restrict__ bg, float* dec_out) {
    LAS float* glrS = (LAS float*)(lds + L_GLR); LAS float* hsum = (LAS float*)(lds + L_HSUM);
    const int d = tid & 255, half = tid >> 8;
    float w[16];
#pragma unroll
    for (int r = 0; r < 16; ++r) w[r] = wg[r * 1024 + h * 256 + d];
    const float bias = bg[h * 256 + d];
    LDS_BAR();
    float gv[32]; float tot = 0.f;
#pragma unroll
    for (int jj = 0; jj < 32; ++jj) { const int j = 32 * half + jj; const float g = j < ntok ? gate_val(glrS + j * 16, w, bias) : 0.f; gv[jj] = g; tot += g; }
    hsum[half * 256 + d] = tot;
    LDS_BAR();
    float run = half ? hsum[d] : 0.f; const float btot = hsum[d] + hsum[256 + d];
    if (MODE == 0) { if (half == 0 && dec_out) dec_out[d] = __expf(btot); }
#pragma unroll
    for (int jb = 0; jb < 4; ++jb) {
        float pk[8];
#pragma unroll
        for (int u = 0; u < 8; ++u) {
            const int j = 32 * half + 8 * jb + u; run += gv[8 * jb + u];
            if (MODE == 0) pk[u] = bf2f(((const LAS bf16_t*)(lds + L_KRAW))[j * QK_P + d]) * __expf(btot - run);
            else {
                LAS bf16_t* qp = (LAS bf16_t*)(lds + L_QT) + j * QK_P + d; LAS bf16_t* kp = (LAS bf16_t*)(lds + L_KT) + j * QK_P + d;
                *qp = (bf16_t)f2bf(bf2f(*qp) * __expf(run)); *kp = (bf16_t)f2bf(bf2f(*kp) * __expf(-run));
            }
        }
        if (MODE == 0) { u32x4 o; o.x = pk2(pk[0], pk[1]); o.y = pk2(pk[2], pk[3]); o.z = pk2(pk[4], pk[5]); o.w = pk2(pk[6], pk[7]);
            *(LAS u32x4*)((LAS bf16_t*)(lds + L_KET) + d * KET_P + 32 * half + 8 * jb) = o; }
    }
}

__device__ __forceinline__ void gla_tile_a(LAS unsigned char* lds, int tid, int row0, int ntok, int h, const float* GLR, const float* wg, const float* bg,
                                           const bf16_t* Kb, const bf16_t* Vb, bf16_t* dsout, float* dec_out) {
    LDS_BAR();
    stage_glr(lds, tid, GLR, row0, ntok);
    stage_rows<32, QK_P>((LAS bf16_t*)(lds + L_KRAW), tid, Kb, 1024, row0, ntok, h * 256);
    stage_rows<64, VS_P>((LAS bf16_t*)(lds + L_VS), tid, Vb, 2048, row0, ntok, h * 512);
    gate_pass<0>(lds, tid, ntok, h, wg, bg, dec_out);
    LDS_BAR();
    const int lane = tid & 63, w = tid >> 6, li = lane & 15, g = lane >> 4;
    const LAS bf16_t* VS = (const LAS bf16_t*)(lds + L_VS); const LAS bf16_t* KET = (const LAS bf16_t*)(lds + L_KET);
#pragma unroll 1
    for (int eb = 0; eb < 4; ++eb) {
        const int e0 = 64 * w + 16 * eb;
        bf16x8 vy[2];
#pragma unroll
        for (int ks = 0; ks < 2; ++ks) { const LAS bf16_t* a = VS + (32 * ks + 8 * g + (li >> 2)) * VS_P + e0 + 4 * (li & 3); vy[ks] = cat8(vtr(a), vtr(a + 4 * VS_P)); }
#pragma unroll
        for (int sb = 0; sb < 4; ++sb) {
            f32x4 acc[4];
#pragma unroll
            for (int db = 0; db < 4; ++db) {
                const LAS bf16_t* kp = KET + (64 * sb + 16 * (li >> 2) + 4 * db + (li & 3)) * KET_P + 8 * g;
                const bf16x8 x0 = *(const LAS bf16x8*)kp, x1 = *(const LAS bf16x8*)(kp + 32);
                f32x4 a = (f32x4){0.f, 0.f, 0.f, 0.f};
                a = MFMA16(x0, vy[0], a); a = MFMA16(x1, vy[1], a); acc[db] = a;
            }
            bf16_t* op = dsout + (size_t)(e0 + li) * 256 + 64 * sb + 16 * g;
            *(u32x4*)op = (u32x4){pk2(acc[0][0], acc[0][1]), pk2(acc[0][2], acc[0][3]), pk2(acc[1][0], acc[1][1]), pk2(acc[1][2], acc[1][3])};
            *(u32x4*)(op + 8) = (u32x4){pk2(acc[2][0], acc[2][1]), pk2(acc[2][2], acc[2][3]), pk2(acc[3][0], acc[3][1]), pk2(acc[3][2], acc[3][3])};
        }
    }
}

__device__ __forceinline__ void gla_tile_c(LAS unsigned char* lds, int tid, int row0, int ntok, int h, const float* GLR, const float* wg, const float* bg,
                                           const bf16_t* Qb, const bf16_t* Kb, const bf16_t* Vb, const bf16_t* __restrict__ Sin, const float* __restrict__ onorm,
                                           const bf16_t* __restrict__ SG, bf16_t* OG) {
    const int lane = tid & 63, w = tid >> 6, li = lane & 15, g = lane >> 4;
    LDS_BAR();
    stage_glr(lds, tid, GLR, row0, ntok);
    stage_rows<32, QK_P>((LAS bf16_t*)(lds + L_QT), tid, Qb, 1024, row0, ntok, h * 256);
    stage_rows<32, QK_P>((LAS bf16_t*)(lds + L_KT), tid, Kb, 1024, row0, ntok, h * 256);
    stage_rows<64, VS_P>((LAS bf16_t*)(lds + L_VS), tid, Vb, 2048, row0, ntok, h * 512);
    const bf16_t* sp = Sin ? Sin + (size_t)(64 * w + 16 * (li >> 2) + (li & 3)) * 256 + 8 * g : nullptr;
    bf16x8 s0[8], s1[8];
    if (Sin) {
#pragma unroll
        for (int ks = 0; ks < 8; ++ks) s0[ks] = *(const bf16x8*)(sp + 32 * ks);
    }
    gate_pass<1>(lds, tid, ntok, h, wg, bg, nullptr);
    LDS_BAR();
    if (Sin) {
#pragma unroll
        for (int ks = 0; ks < 8; ++ks) s1[ks] = *(const bf16x8*)(sp + (size_t)4 * 256 + 32 * ks);
    }
    const LAS bf16_t* VS = (const LAS bf16_t*)(lds + L_VS); const LAS bf16_t* QT = (const LAS bf16_t*)(lds + L_QT); const LAS bf16_t* KT = (const LAS bf16_t*)(lds + L_KT);
    LAS bf16_t* ATT = (LAS bf16_t*)(lds + L_KT);
    const int ib0 = w >> 1;
    f32x4 at[2];
#pragma unroll
    for (int jj = 0; jj < 2; ++jj) {
        const int jb = 2 * (w & 1) + jj; f32x4 a = (f32x4){0.f, 0.f, 0.f, 0.f};
        if (jb <= ib0) {
#pragma unroll
            for (int ks = 0; ks < 8; ++ks) { const bf16x8 x = *(const LAS bf16x8*)(KT + (16 * jb + li) * QK_P + 32 * ks + 8 * g); const bf16x8 y = *(const LAS bf16x8*)(QT + (16 * ib0 + li) * QK_P + 32 * ks + 8 * g); a = MFMA16(x, y, a); }
        }
        const int i = 16 * ib0 + li;
#pragma unroll
        for (int r = 0; r < 4; ++r) { const int j = 16 * jb + 4 * g + r; if (j > i) a[r] = 0.f; }
        at[jj] = a;
    }
    LDS_BAR();
#pragma unroll
    for (int jj = 0; jj < 2; ++jj) { const int jb = 2 * (w & 1) + jj;
        *(LAS u32x2*)(ATT + (16 * ib0 + li) * ATT_P + 16 * jb + 4 * g) = (u32x2){pk2(at[jj][0], at[jj][1]), pk2(at[jj][2], at[jj][3])}; }
    LDS_BAR();
    f32x4 acc[4][4];
#pragma unroll
    for (int a = 0; a < 4; ++a)
#pragma unroll
        for (int b = 0; b < 4; ++b) acc[a][b] = (f32x4){0.f, 0.f, 0.f, 0.f};
#pragma unroll
    for (int eb = 0; eb < 4; ++eb) {
#pragma unroll
        for (int ks = 0; ks < 2; ++ks) {
            const LAS bf16_t* a = VS + (32 * ks + 8 * g + (li >> 2)) * VS_P + 64 * w + 16 * (li & 3) + 4 * eb; const bf16x8 x = cat8(vtr(a), vtr(a + 4 * VS_P));
#pragma unroll
            for (int ib = 0; ib < 4; ++ib) { const bf16x8 y = *(const LAS bf16x8*)(ATT + (16 * ib + li) * ATT_P + 32 * ks + 8 * g); acc[eb][ib] = MFMA16(x, y, acc[eb][ib]); }
        }
        if (Sin) {
#pragma unroll
            for (int ks = 0; ks < 8; ++ks) {
                const bf16x8 x = (eb & 1) ? s1[ks] : s0[ks];
#pragma unroll
                for (int ib = 0; ib < 4; ++ib) { const bf16x8 y = *(const LAS bf16x8*)(QT + (16 * ib + li) * QK_P + 32 * ks + 8 * g); acc[eb][ib] = MFMA16(x, y, acc[eb][ib]); }
            }
            if (eb < 2) {
#pragma unroll
                for (int ks = 0; ks < 8; ++ks) { const bf16x8 nv = *(const bf16x8*)(sp + (size_t)(4 * (eb + 2)) * 256 + 32 * ks); if (eb & 1) s1[ks] = nv; else s0[ks] = nv; }
            }
        }
    }
    LAS float* rowsq = (LAS float*)(lds + L_ROWSQ);
#pragma unroll
    for (int ib = 0; ib < 4; ++ib) { float ss = 0.f;
#pragma unroll
        for (int eb = 0; eb < 4; ++eb) { const f32x4 v = acc[eb][ib]; ss += (v[0] * v[0] + v[1] * v[1]) + (v[2] * v[2] + v[3] * v[3]); }
        ss += __shfl_xor(ss, 16); ss += __shfl_xor(ss, 32);
        if (g == 0) rowsq[(16 * ib + li) * 8 + w] = ss; }
    LDS_BAR();
    const int e = 64 * w + 16 * g;
    f32x4 on[4];
#pragma unroll
    for (int q = 0; q < 4; ++q) on[q] = *(const f32x4*)(onorm + e + 4 * q);
#pragma unroll
    for (int ib = 0; ib < 4; ++ib) { const int i = 16 * ib + li;
        const f32x4 q0 = *(const LAS f32x4*)(rowsq + i * 8), q1 = *(const LAS f32x4*)(rowsq + i * 8 + 4);
        const float rinv = rsqrtf(((q0[0] + q0[1]) + (q0[2] + q0[3]) + (q1[0] + q1[1]) + (q1[2] + q1[3])) * (1.0f / 512.0f) + EPS);
        if (i < ntok) {
            const size_t off = (size_t)(row0 + i) * 2048 + h * 512 + e;
            const u32x4 g0 = *(const u32x4*)(SG + off), g1 = *(const u32x4*)(SG + off + 8);
            const f32x4 v0 = acc[0][ib] * on[0] * rinv, v1 = acc[1][ib] * on[1] * rinv, v2 = acc[2][ib] * on[2] * rinv, v3 = acc[3][ib] * on[3] * rinv;
            *(u32x4*)(OG + off) = (u32x4){pk2(v0[0] * bflo(g0.x), v0[1] * bfhi(g0.x)), pk2(v0[2] * bflo(g0.y), v0[3] * bfhi(g0.y)), pk2(v1[0] * bflo(g0.z), v1[1] * bfhi(g0.z)), pk2(v1[2] * bflo(g0.w), v1[3] * bfhi(g0.w))};
            *(u32x4*)(OG + off + 8) = (u32x4){pk2(v2[0] * bflo(g1.x), v2[1] * bfhi(g1.x)), pk2(v2[2] * bflo(g1.y), v2[3] * bfhi(g1.y)), pk2(v3[0] * bflo(g1.z), v3[1] * bfhi(g1.z)), pk2(v3[2] * bflo(g1.w), v3[3] * bfhi(g1.w))};
        }
    }
}

__device__ __forceinline__ void gla_tile_sample(LAS unsigned char* lds, int tid, int bs, int h, int eh, const float* GLR, const float* wg, const float* bg,
                                                const bf16_t* Qb, const bf16_t* Kb, const bf16_t* Vb, const float* __restrict__ S0, float* __restrict__ Sout, float* ORAW) {
    __syncthreads();
    LAS float* coef = (LAS float*)lds;
    LAS float* glrS = (LAS float*)(lds + 16384);
    LAS float* red = (LAS float*)(lds + 16640);
    LAS float* attS = (LAS float*)(lds + 16896);
    LAS float* ored = (LAS float*)(lds + 20480);
    const int row0 = ROW_SAMP + 4 * bs, lane = tid & 63, wv = tid >> 6;
    if (tid < 64) glrS[tid] = GLR[(size_t)row0 * 16 + tid];
    __syncthreads();
    if (tid < 256) {
        const int d = tid; float w[16];
#pragma unroll
        for (int r = 0; r < 16; ++r) w[r] = wg[r * 1024 + h * 256 + d];
        const float bias = bg[h * 256 + d];
        float b[4], run = 0.f;
#pragma unroll
        for (int t = 0; t < 4; ++t) { run += gate_val(glrS + t * 16, w, bias); b[t] = run; }
        float qd[4], kd[4];
#pragma unroll
        for (int t = 0; t < 4; ++t) { const float q = bf2f(Qb[(size_t)(row0 + t) * 1024 + h * 256 + d]), k = bf2f(Kb[(size_t)(row0 + t) * 1024 + h * 256 + d]);
            qd[t] = q * __expf(b[t]); kd[t] = k * __expf(-b[t]); coef[d * 12 + t] = qd[t]; coef[d * 12 + 4 + t] = k * __expf(run - b[t]); }
        coef[d * 12 + 8] = __expf(run);
#pragma unroll
        for (int t = 0; t < 4; ++t)
#pragma unroll
            for (int j = 0; j <= t; ++j) { const float s = wave_sum(qd[t] * kd[j]); if (lane == 0) red[wv * 10 + t * (t + 1) / 2 + j] = s; }
    }
    __syncthreads();
    if (tid < 10) attS[tid] = (red[tid] + red[10 + tid]) + (red[20 + tid] + red[30 + tid]);
    const int e4 = tid & 63, e = eh * 256 + 4 * e4;
    f32x4 v[4];
#pragma unroll
    for (int j = 0; j < 4; ++j) { const u32x2 raw = *(const u32x2*)(Vb + (size_t)(row0 + j) * 2048 + h * 512 + e); v[j] = (f32x4){bflo(raw.x), bfhi(raw.x), bflo(raw.y), bfhi(raw.y)}; }
    f32x4 o[4];
#pragma unroll
    for (int t = 0; t < 4; ++t) o[t] = (f32x4){0.f, 0.f, 0.f, 0.f};
    f32x4 sbuf[16];
#pragma unroll
    for (int it = 0; it < 16; ++it) sbuf[it] = __builtin_nontemporal_load((const f32x4*)(S0 + (size_t)(wv + 8 * it) * 512 + e));
#pragma unroll
    for (int it = 0; it < 32; ++it) {
        const int d = wv + 8 * it;
        const f32x4 s = sbuf[it & 15];
        if (it + 16 < 32) sbuf[it & 15] = __builtin_nontemporal_load((const f32x4*)(S0 + (size_t)(wv + 8 * (it + 16)) * 512 + e));
        const f32x4 c0 = *(const LAS f32x4*)(coef + d * 12), c1 = *(const LAS f32x4*)(coef + d * 12 + 4); const float dc = coef[d * 12 + 8];
#pragma unroll
        for (int t = 0; t < 4; ++t) o[t] += s * c0[t];
        f32x4 sn = s * dc;
#pragma unroll
        for (int j = 0; j < 4; ++j) sn += v[j] * c1[j];
        __builtin_nontemporal_store(sn, (f32x4*)(Sout + (size_t)d * 512 + e));
    }
#pragma unroll
    for (int t = 0; t < 4; ++t) *(LAS f32x4*)(ored + (wv * 4 + t) * 256 + 4 * e4) = o[t];
    __syncthreads();
    if (tid < 256) {
        float vv[4];
#pragma unroll
        for (int j = 0; j < 4; ++j) vv[j] = bf2f(Vb[(size_t)(row0 + j) * 2048 + h * 512 + eh * 256 + tid]);
#pragma unroll
        for (int t = 0; t < 4; ++t) { float s = 0.f;
#pragma unroll
            for (int q = 0; q < 8; ++q) s += ored[(q * 4 + t) * 256 + tid];
#pragma unroll
            for (int j = 0; j <= t; ++j) s += attS[t * (t + 1) / 2 + j] * vv[j];
            ORAW[((size_t)(bs * 4 + h) * 4 + t) * 512 + eh * 256 + tid] = s; }
    }
}

__device__ __forceinline__ void gla_tile_sample_full(LAS unsigned char* lds, int tid, int bs, int h, const float* GLR, const float* wg, const float* bg,
                                                     const bf16_t* Qb, const bf16_t* Kb, const bf16_t* Vb, const float* __restrict__ S0, float* __restrict__ Sout,
                                                     const float* __restrict__ onorm, const bf16_t* __restrict__ SG, bf16_t* OG) {
    LDS_BAR();
    LAS float* coef = (LAS float*)lds;
    LAS float* glrS = (LAS float*)(lds + 16384);
    LAS float* red = (LAS float*)(lds + 16640);
    LAS float* attS = (LAS float*)(lds + 16896);
    LAS float* ored = (LAS float*)(lds + 20480);
    LAS float* ssqS = (LAS float*)(lds + 20480 + 32768);
    const int row0 = ROW_SAMP + 4 * bs, lane = tid & 63, wv = tid >> 6;
    if (tid < 64) glrS[tid] = GLR[(size_t)row0 * 16 + tid];
    LDS_BAR();
    if (tid < 256) {
        const int d = tid; float w[16];
#pragma unroll
        for (int r = 0; r < 16; ++r) w[r] = wg[r * 1024 + h * 256 + d];
        const float bias = bg[h * 256 + d];
        float b[4], run = 0.f;
#pragma unroll
        for (int t = 0; t < 4; ++t) { run += gate_val(glrS + t * 16, w, bias); b[t] = run; }
        float qd[4], kd[4];
#pragma unroll
        for (int t = 0; t < 4; ++t) { const float q = bf2f(Qb[(size_t)(row0 + t) * 1024 + h * 256 + d]), k = bf2f(Kb[(size_t)(row0 + t) * 1024 + h * 256 + d]);
            qd[t] = q * __expf(b[t]); kd[t] = k * __expf(-b[t]); coef[d * 12 + t] = qd[t]; coef[d * 12 + 4 + t] = k * __expf(run - b[t]); }
        coef[d * 12 + 8] = __expf(run);
#pragma unroll
        for (int t = 0; t < 4; ++t)
#pragma unroll
            for (int j = 0; j <= t; ++j) { const float s = wave_sum(qd[t] * kd[j]); if (lane == 0) red[wv * 10 + t * (t + 1) / 2 + j] = s; }
    }
    LDS_BAR();
    if (tid < 10) attS[tid] = (red[tid] + red[10 + tid]) + (red[20 + tid] + red[30 + tid]);
    const int e4 = tid & 127, e = 4 * e4, dsub = tid >> 7;
    f32x4 v[4];
#pragma unroll
    for (int j = 0; j < 4; ++j) { const u32x2 raw = *(const u32x2*)(Vb + (size_t)(row0 + j) * 2048 + h * 512 + e); v[j] = (f32x4){bflo(raw.x), bfhi(raw.x), bflo(raw.y), bfhi(raw.y)}; }
    f32x4 o[4];
#pragma unroll
    for (int t = 0; t < 4; ++t) o[t] = (f32x4){0.f, 0.f, 0.f, 0.f};
    f32x4 sbuf[16];
#pragma unroll
    for (int it = 0; it < 16; ++it) sbuf[it] = __builtin_nontemporal_load((const f32x4*)(S0 + (size_t)(dsub + 4 * it) * 512 + e));
#pragma unroll
    for (int it = 0; it < 64; ++it) {
        const int d = dsub + 4 * it;
        const f32x4 s = sbuf[it & 15];
        if (it + 16 < 64) sbuf[it & 15] = __builtin_nontemporal_load((const f32x4*)(S0 + (size_t)(dsub + 4 * (it + 16)) * 512 + e));
        const f32x4 c0 = *(const LAS f32x4*)(coef + d * 12), c1 = *(const LAS f32x4*)(coef + d * 12 + 4); const float dc = coef[d * 12 + 8];
#pragma unroll
        for (int t = 0; t < 4; ++t) o[t] += s * c0[t];
        f32x4 sn = s * dc;
#pragma unroll
        for (int j = 0; j < 4; ++j) sn += v[j] * c1[j];
        __builtin_nontemporal_store(sn, (f32x4*)(Sout + (size_t)d * 512 + e));
    }
#pragma unroll
    for (int t = 0; t < 4; ++t) *(LAS f32x4*)(ored + (dsub * 4 + t) * 512 + 4 * e4) = o[t];
    LDS_BAR();
    float of[4], vv[4];
#pragma unroll
    for (int j = 0; j < 4; ++j) vv[j] = bf2f(Vb[(size_t)(row0 + j) * 2048 + h * 512 + tid]);
#pragma unroll
    for (int t = 0; t < 4; ++t) { float s = (ored[(0 * 4 + t) * 512 + tid] + ored[(1 * 4 + t) * 512 + tid]) + (ored[(2 * 4 + t) * 512 + tid] + ored[(3 * 4 + t) * 512 + tid]);
#pragma unroll
        for (int j = 0; j <= t; ++j) s += attS[t * (t + 1) / 2 + j] * vv[j];
        of[t] = s; const float q = wave_sum(s * s); if (lane == 0) ssqS[wv * 4 + t] = q; }
    LDS_BAR();
    const float on = onorm[tid];
#pragma unroll
    for (int t = 0; t < 4; ++t) { float tot = 0.f;
#pragma unroll
        for (int q = 0; q < 8; ++q) tot += ssqS[q * 4 + t];
        const float rinv = rsqrtf(tot * (1.0f / 512.0f) + EPS);
        const size_t off = (size_t)(row0 + t) * 2048 + h * 512 + tid;
        OG[off] = (bf16_t)pk2(of[t] * rinv * on * bf2f(SG[off]), 0.f); }
}

__device__ __forceinline__ void gla_tile_sample_fin(int tid, int bs, const float* __restrict__ ORAW, const float* __restrict__ onorm, const bf16_t* __restrict__ SG, bf16_t* OG) {
    const int lane = tid & 63, wv = tid >> 6;
#pragma unroll
    for (int rr = 0; rr < 2; ++rr) { const int rowid = 2 * wv + rr, h = rowid >> 2, t = rowid & 3; const int row = ROW_SAMP + 4 * bs + t;
        const float* op = ORAW + ((size_t)(bs * 4 + h) * 4 + t) * 512 + 8 * lane;
        const f32x4 a = *(const f32x4*)op, b = *(const f32x4*)(op + 4);
        float ss = (a[0] * a[0] + a[1] * a[1]) + (a[2] * a[2] + a[3] * a[3]) + (b[0] * b[0] + b[1] * b[1]) + (b[2] * b[2] + b[3] * b[3]);
        ss = wave_sum(ss); const float rinv = rsqrtf(ss * (1.0f / 512.0f) + EPS);
        const size_t off = (size_t)row * 2048 + h * 512 + 8 * lane; const u32x4 sg = *(const u32x4*)(SG + off);
        const f32x4 n0 = *(const f32x4*)(onorm + 8 * lane), n1 = *(const f32x4*)(onorm + 8 * lane + 4);
        u32x4 o; o.x = pk2(a[0] * rinv * n0[0] * bflo(sg.x), a[1] * rinv * n0[1] * bfhi(sg.x)); o.y = pk2(a[2] * rinv * n0[2] * bflo(sg.y), a[3] * rinv * n0[3] * bfhi(sg.y));
        o.z = pk2(b[0] * rinv * n1[0] * bflo(sg.z), b[1] * rinv * n1[1] * bfhi(sg.z)); o.w = pk2(b[2] * rinv * n1[2] * bflo(sg.w), b[3] * rinv * n1[3] * bfhi(sg.w));
        *(u32x4*)(OG + off) = o; }
}

__device__ __forceinline__ void gla_scan(LAS unsigned char* lds, int tid, int bid, int G, bf16_t* DS, const bf16_t* __restrict__ DSM, const float* __restrict__ DEC, float* __restrict__ sp_out) {
    LAS float* decS = (LAS float*)lds;
    LAS float* stT = (LAS float*)(lds + 65536);
#pragma unroll 1
    for (int blk = bid; blk < 256; blk += G) {
        const int bh = blk >> 5, b = bh >> 2, h = bh & 3, e0 = (blk & 31) * 16, el = tid >> 5, e = e0 + el, d8 = tid & 31;
        LDS_BAR();
#pragma unroll
        for (int i = 0; i < 8; ++i) { const int idx = tid + NTHR * i, c = idx >> 6, q = idx & 63;
            *(LAS f32x4*)(decS + c * 256 + q * 4) = *(const f32x4*)(DEC + ((size_t)(b * 64 + c) * 4 + h) * 256 + q * 4); }
        float S[8];
        { const u32x4 m = *(const u32x4*)(DSM + ((size_t)h * 512 + e) * 256 + d8 * 8);
          S[0] = bflo(m.x); S[1] = bfhi(m.x); S[2] = bflo(m.y); S[3] = bfhi(m.y); S[4] = bflo(m.z); S[5] = bfhi(m.z); S[6] = bflo(m.w); S[7] = bfhi(m.w); }
        bf16_t* dsp = DS + (((size_t)(b * 64) * 4 + h) * 512 + e) * 256 + d8 * 8;
        constexpr size_t CS = (size_t)4 * 512 * 256;
        u32x4 buf[16];
#pragma unroll
        for (int u = 0; u < 16; ++u) buf[u] = *(const u32x4*)(dsp + u * CS);
        LDS_BAR();
#pragma unroll
        for (int c = 0; c < 64; ++c) { const u32x4 dv = buf[c & 15];
            if (c + 16 < 64) buf[c & 15] = *(const u32x4*)(dsp + (size_t)(c + 16) * CS);
            const f32x4 d0 = *(const LAS f32x4*)(decS + c * 256 + d8 * 8), d1 = *(const LAS f32x4*)(decS + c * 256 + d8 * 8 + 4);
            u32x4 o; o.x = pk2(S[0], S[1]); o.y = pk2(S[2], S[3]); o.z = pk2(S[4], S[5]); o.w = pk2(S[6], S[7]);
            *(u32x4*)(dsp + c * CS) = o;
            S[0] = S[0] * d0[0] + bflo(dv.x); S[1] = S[1] * d0[1] + bfhi(dv.x); S[2] = S[2] * d0[2] + bflo(dv.y); S[3] = S[3] * d0[3] + bfhi(dv.y);
            S[4] = S[4] * d1[0] + bflo(dv.z); S[5] = S[5] * d1[1] + bfhi(dv.z); S[6] = S[6] * d1[2] + bflo(dv.w); S[7] = S[7] * d1[3] + bfhi(dv.w); }
#pragma unroll
        for (int u = 0; u < 8; ++u) stT[(d8 * 8 + u) * 17 + el] = S[u];
        LDS_BAR();
#pragma unroll
        for (int i = 0; i < 8; ++i) { const int idx = tid + NTHR * i, d = idx >> 4, q = idx & 15;
            sp_out[((size_t)bh * 256 + d) * 512 + e0 + q] = stT[d * 17 + q]; }
    }
}

template <class Epi>
__device__ __forceinline__ void tail_gemm_unit(LAS unsigned char* lds, int tid, const bf16_t* __restrict__ A, const bf16_t* __restrict__ Bt, int n0, int rh, const Epi& E) {
    const int lane = tid & 63, w = tid >> 6, li = lane & 15, g = lane >> 4;
    const bf16_t* ap = A + (size_t)(ROW_META + 80 * rh + li) * DM + 256 * w + 8 * g;
    const bf16_t* bp = Bt + (size_t)(n0 + 16 * (li >> 2) + (li & 3)) * DM + 256 * w + 8 * g;
    f32x4 acc[5][4];
#pragma unroll
    for (int a = 0; a < 5; ++a)
#pragma unroll
        for (int b = 0; b < 4; ++b) acc[a][b] = (f32x4){0.f, 0.f, 0.f, 0.f};
    bf16x8 fa[3][5], fb[3][4];
#define TG_LOAD(st, ks) do { _Pragma("unroll") for (int q_ = 0; q_ < 5; ++q_) fa[st][q_] = *(const bf16x8*)(ap + (size_t)(16 * q_) * DM + 32 * (ks)); \
                             _Pragma("unroll") for (int q_ = 0; q_ < 4; ++q_) fb[st][q_] = *(const bf16x8*)(bp + (size_t)(4 * q_) * DM + 32 * (ks)); } while (0)
    TG_LOAD(0, 0); TG_LOAD(1, 1); TG_LOAD(2, 2);
#pragma unroll
    for (int ks = 0; ks < 8; ++ks) {
#pragma unroll
        for (int rb = 0; rb < 5; ++rb)
#pragma unroll
            for (int cb = 0; cb < 4; ++cb) acc[rb][cb] = MFMA16(fb[ks % 3][cb], fa[ks % 3][rb], acc[rb][cb]);
        if (ks + 3 < 8) TG_LOAD(ks % 3, ks + 3);
    }
#undef TG_LOAD
    LAS f32x4* red = (LAS f32x4*)lds;
    LDS_BAR();
    if (w >= 4) {
#pragma unroll
        for (int rb = 0; rb < 5; ++rb)
#pragma unroll
            for (int cb = 0; cb < 4; ++cb) red[((w - 4) * 20 + rb * 4 + cb) * 64 + lane] = acc[rb][cb];
    }
    LDS_BAR();
    if (w < 4) {
#pragma unroll
        for (int rb = 0; rb < 5; ++rb)
#pragma unroll
            for (int cb = 0; cb < 4; ++cb) acc[rb][cb] += red[(w * 20 + rb * 4 + cb) * 64 + lane];
    }
    LDS_BAR();
    if (w < 4) {
#pragma unroll
        for (int rb = 0; rb < 5; ++rb)
#pragma unroll
            for (int cb = 0; cb < 4; ++cb) red[(w * 20 + rb * 4 + cb) * 64 + lane] = acc[rb][cb];
    }
    LDS_BAR();
    if (w < 5 && rh * 5 + w < 9) {
        f32x4 v[4];
#pragma unroll
        for (int cb = 0; cb < 4; ++cb) v[cb] = (red[(0 * 20 + w * 4 + cb) * 64 + lane] + red[(1 * 20 + w * 4 + cb) * 64 + lane]) + (red[(2 * 20 + w * 4 + cb) * 64 + lane] + red[(3 * 20 + w * 4 + cb) * 64 + lane]);
        E.tail16(ROW_META + 80 * rh + 16 * w + li, n0 + 16 * g, v[0], v[1], v[2], v[3]);
    }
}

__device__ __forceinline__ void glr_unit(LAS unsigned char* lds, int tid, const bf16_t* __restrict__ A, const bf16_t* __restrict__ Bt, int unit, const float* __restrict__ ssq, float* GLR) {
    const int lane = tid & 63, w = tid >> 6, li = lane & 15, g = lane >> 4;
    const bf16_t* ap = A + (size_t)(32 * unit + li) * DM + 256 * w + 8 * g;
    const bf16_t* bp = Bt + (size_t)(6144 + li) * DM + 256 * w + 8 * g;
    bf16x8 fa[8][2], fb[8];
#pragma unroll
    for (int ks = 0; ks < 8; ++ks) { fa[ks][0] = *(const bf16x8*)(ap + 32 * ks); fa[ks][1] = *(const bf16x8*)(ap + (size_t)16 * DM + 32 * ks); fb[ks] = *(const bf16x8*)(bp + 32 * ks); }
    f32x4 acc[2] = {(f32x4){0.f, 0.f, 0.f, 0.f}, (f32x4){0.f, 0.f, 0.f, 0.f}};
#pragma unroll
    for (int ks = 0; ks < 8; ++ks) { acc[0] = MFMA16(fb[ks], fa[ks][0], acc[0]); acc[1] = MFMA16(fb[ks], fa[ks][1], acc[1]); }
    LAS f32x4* red = (LAS f32x4*)lds;
    LDS_BAR();
    red[(w * 2 + 0) * 64 + lane] = acc[0]; red[(w * 2 + 1) * 64 + lane] = acc[1];
    LDS_BAR();
    if (w < 2) {
        f32x4 s = (f32x4){0.f, 0.f, 0.f, 0.f};
#pragma unroll
        for (int q = 0; q < 8; ++q) s += red[(q * 2 + w) * 64 + lane];
        const int row = 32 * unit + 16 * w + li; const float rs = pg8::row_rinv(ssq, row);
        *(f32x4*)(GLR + (size_t)row * 16 + 4 * g) = s * rs;
    }
    LDS_BAR();
}
constexpr int KS_P = 72;
constexpr int L_KS = 0, L_VS2 = 192 * KS_P * 2;
__device__ __forceinline__ int seq_row(int t, int b) { return t >= 0 ? b * 4096 + t : ROW_META + 16 + t; }

constexpr int L_VS2B = 256 * KS_P * 2;
__device__ __forceinline__ void swa_tile(LAS unsigned char* lds, int tid, int b, int tq0, int kvh, int nq, const bf16_t* __restrict__ KV, const bf16_t* __restrict__ QS,
                                         const bf16_t* __restrict__ SG, const float* __restrict__ sinks, bf16_t* OG) {
    const int lane = tid & 63, w = tid >> 6, li = lane & 15, g = lane >> 4, hg = w >> 1, qh = w & 1, head = kvh * 4 + hg;
    LAS bf16_t* KS = (LAS bf16_t*)(lds + L_KS); LAS bf16_t* VS = (LAS bf16_t*)(lds + L_VS2B);
    bf16x8 qa[2][2], qn[2][2];
#pragma unroll
    for (int qb = 0; qb < 2; ++qb) { const int i = 32 * qh + 16 * qb + li; const size_t rq = (size_t)seq_row(tq0 + i, b) * 2048 + head * 64;
        qa[qb][0] = *(const bf16x8*)(QS + rq + 8 * g); qa[qb][1] = *(const bf16x8*)(QS + rq + 8 * g + 32); }
    const float sink = sinks[head];
    LDS_BAR();
#pragma unroll
    for (int i = 0; i < 8; ++i) { const int chunk = tid + NTHR * i, kk = chunk >> 4, c = chunk & 15, isv = c >> 3, c8 = c & 7; const int t = tq0 - 128 + kk;
        u32x4 v = (u32x4){0u, 0u, 0u, 0u}; if (t >= -16 && t < 4096) v = *(const u32x4*)(KV + (size_t)seq_row(t, b) * 1024 + isv * 512 + kvh * 64 + c8 * 8);
        *(LAS u32x4*)((isv ? VS : KS) + kk * KS_P + c8 * 8) = v; }
    LDS_BAR();
#pragma unroll
    for (int h2 = 0; h2 < 2; ++h2) {
        const int kb0 = 4 * h2 + 2 * qh;
        if (h2 == 0) {
#pragma unroll
            for (int qb = 0; qb < 2; ++qb) { const int i = 64 + 32 * qh + 16 * qb + li; const size_t rq = (size_t)seq_row(tq0 + i, b) * 2048 + head * 64; qn[qb][0] = *(const bf16x8*)(QS + rq + 8 * g); qn[qb][1] = *(const bf16x8*)(QS + rq + 8 * g + 32); }
        }
#pragma unroll
        for (int qb = 0; qb < 2; ++qb) {
            if (64 * h2 + 32 * qh + 16 * qb >= nq) continue;
            const int i = 64 * h2 + 32 * qh + 16 * qb + li; const size_t ro = (size_t)seq_row(tq0 + i, b) * 2048 + head * 64 + 16 * g;
            const u32x4 g0 = *(const u32x4*)(SG + ro), g1 = *(const u32x4*)(SG + ro + 8);
            f32x4 s[10];
#pragma unroll
            for (int kb = 0; kb < 10; ++kb) { const LAS bf16_t* kp = KS + (16 * (kb0 + kb) + li) * KS_P + 8 * g;
                const bf16x8 x0 = *(const LAS bf16x8*)kp, x1 = *(const LAS bf16x8*)(kp + 32);
                f32x4 a = (f32x4){0.f, 0.f, 0.f, 0.f}; a = MFMA16(x0, qa[qb][0], a); a = MFMA16(x1, qa[qb][1], a); s[kb] = a;
                if (kb == 3 || kb == 6) asm volatile("" ::: "memory"); }
            float m = -1e30f;
#pragma unroll
            for (int kb = 0; kb < 10; ++kb)
#pragma unroll
                for (int r = 0; r < 4; ++r) { const int kk = 16 * (kb0 + kb) + 4 * g + r; const bool ok = (kk > i) && (kk <= i + 128) && (tq0 - 128 + kk >= -16);
                    if (!ok) s[kb][r] = -1e30f; m = fmaxf(m, s[kb][r]); }
            m = fmaxf(m, __shfl_xor(m, 16)); m = fmaxf(m, __shfl_xor(m, 32)); m = fmaxf(m, sink);
            float sum = 0.f;
#pragma unroll
            for (int kb = 0; kb < 10; ++kb)
#pragma unroll
                for (int r = 0; r < 4; ++r) { const float pv = s[kb][r] > -1e29f ? __expf(s[kb][r] - m) : 0.f; s[kb][r] = pv; sum += pv; }
            sum += __shfl_xor(sum, 16); sum += __shfl_xor(sum, 32);
            const float inv = 1.0f / (sum + __expf(sink - m));
            f32x4 o[4];
#pragma unroll
            for (int c4 = 0; c4 < 4; ++c4) o[c4] = (f32x4){0.f, 0.f, 0.f, 0.f};
#pragma unroll
            for (int k2 = 0; k2 < 5; ++k2) {
                const int kbase = 16 * kb0 + 32 * k2;
                const f32x4 a = s[2 * k2], cc = s[2 * k2 + 1]; u32x4 pw; pw.x = pk2(a[0], a[1]); pw.y = pk2(a[2], a[3]); pw.z = pk2(cc[0], cc[1]); pw.w = pk2(cc[2], cc[3]);
                const bf16x8 y = __builtin_bit_cast(bf16x8, pw);
#pragma unroll
                for (int db = 0; db < 4; ++db) { const LAS bf16_t* ap = VS + (kbase + 4 * g + (li >> 2)) * KS_P + 16 * (li & 3) + 4 * db; const bf16x8 x = cat8(vtr(ap), vtr(ap + 16 * KS_P));
                    o[db] = MFMA16(x, y, o[db]); }
            }
            if (i < nq) { const f32x4 v0 = o[0] * inv, v1 = o[1] * inv, v2 = o[2] * inv, v3 = o[3] * inv;
                *(u32x4*)(OG + ro) = (u32x4){pk2(v0[0] * bflo(g0.x), v0[1] * bfhi(g0.x)), pk2(v0[2] * bflo(g0.y), v0[3] * bfhi(g0.y)), pk2(v1[0] * bflo(g0.z), v1[1] * bfhi(g0.z)), pk2(v1[2] * bflo(g0.w), v1[3] * bfhi(g0.w))};
                *(u32x4*)(OG + ro + 8) = (u32x4){pk2(v2[0] * bflo(g1.x), v2[1] * bfhi(g1.x)), pk2(v2[2] * bflo(g1.y), v2[3] * bfhi(g1.y)), pk2(v3[0] * bflo(g1.z), v3[1] * bfhi(g1.z)), pk2(v3[2] * bflo(g1.w), v3[3] * bfhi(g1.w))}; }
        }
        if (h2 == 0) {
#pragma unroll
            for (int qb = 0; qb < 2; ++qb) { qa[qb][0] = qn[qb][0]; qa[qb][1] = qn[qb][1]; } }
    }
}

__device__ __forceinline__ void swa_decode_tile(LAS unsigned char* lds, int tid, int bs, int kvh, const float* __restrict__ ck, const float* __restrict__ cv, const bf16_t* __restrict__ KV,
                                                const bf16_t* __restrict__ QS, const bf16_t* __restrict__ SG, const float* __restrict__ sinks, bf16_t* OG) {
    LAS bf16_t* KS = (LAS bf16_t*)lds;
    LAS bf16_t* VS = (LAS bf16_t*)(lds + 144 * KS_P * 2);
    const int row0 = ROW_SAMP + 4 * bs, lane = tid & 63, w = tid >> 6, li = lane & 15, g = lane >> 4;
    f32x4 kl[4], vl[4];
#pragma unroll
    for (int i = 0; i < 4; ++i) { const int idx = tid + NTHR * i, key = idx >> 4, c4 = idx & 15; const size_t o = ((size_t)(bs * 128 + key) * 8 + kvh) * 64 + 4 * c4;
        kl[i] = __builtin_nontemporal_load((const f32x4*)(ck + o)); vl[i] = __builtin_nontemporal_load((const f32x4*)(cv + o)); }
    u32x2 kn = (u32x2){0u, 0u}, vn = (u32x2){0u, 0u};
    if (tid < 64) { const size_t o = (size_t)(row0 + (tid >> 4)) * 1024 + kvh * 64 + 4 * (tid & 15); kn = *(const u32x2*)(KV + o); vn = *(const u32x2*)(KV + o + 512); }
    const int tq = li >> 2, head = kvh * 4 + (li & 3);
    const size_t rq = (size_t)(row0 + tq) * 2048 + head * 64;
    bf16x8 qf0, qf1; u32x4 g0, g1; float sink = 0.f;
    if (w == 0) { qf0 = *(const bf16x8*)(QS + rq + 8 * g); qf1 = *(const bf16x8*)(QS + rq + 8 * g + 32); g0 = *(const u32x4*)(SG + rq + 16 * g); g1 = *(const u32x4*)(SG + rq + 16 * g + 8); sink = sinks[head]; }
    LDS_BAR();
#pragma unroll
    for (int i = 0; i < 4; ++i) { const int idx = tid + NTHR * i, key = idx >> 4, c4 = idx & 15;
        *(LAS u32x2*)(KS + key * KS_P + 4 * c4) = (u32x2){pk2(kl[i][0], kl[i][1]), pk2(kl[i][2], kl[i][3])};
        *(LAS u32x2*)(VS + key * KS_P + 4 * c4) = (u32x2){pk2(vl[i][0], vl[i][1]), pk2(vl[i][2], vl[i][3])}; }
    if (tid < 64) { *(LAS u32x2*)(KS + (128 + (tid >> 4)) * KS_P + 4 * (tid & 15)) = kn; *(LAS u32x2*)(VS + (128 + (tid >> 4)) * KS_P + 4 * (tid & 15)) = vn; }
    else { const int idx = tid - 64; if (idx < 12 * 16) *(LAS u32x2*)(KS + (132 + (idx >> 4)) * KS_P + 4 * (idx & 15)) = (u32x2){0u, 0u};
           if (idx < 28 * 16) *(LAS u32x2*)(VS + (132 + (idx >> 4)) * KS_P + 4 * (idx & 15)) = (u32x2){0u, 0u}; }
    LDS_BAR();
    if (w == 0) {
        f32x4 s[10];
#pragma unroll
        for (int kb = 0; kb < 9; ++kb) { const LAS bf16_t* kp = KS + (16 * kb + li) * KS_P + 8 * g;
            const bf16x8 x0 = *(const LAS bf16x8*)kp, x1 = *(const LAS bf16x8*)(kp + 32);
            f32x4 a = (f32x4){0.f, 0.f, 0.f, 0.f}; a = MFMA16(x0, qf0, a); a = MFMA16(x1, qf1, a); s[kb] = a; }
        s[9] = (f32x4){-1e30f, -1e30f, -1e30f, -1e30f};
        float m = -1e30f;
#pragma unroll
        for (int kb = 0; kb < 9; ++kb)
#pragma unroll
            for (int r = 0; r < 4; ++r) { const int kk = 16 * kb + 4 * g + r; const bool ok = kk < 128 ? (kk >= tq + 1) : (kk < 132 && kk - 128 <= tq);
                if (!ok) s[kb][r] = -1e30f; m = fmaxf(m, s[kb][r]); }
        m = fmaxf(m, __shfl_xor(m, 16)); m = fmaxf(m, __shfl_xor(m, 32)); m = fmaxf(m, sink);
        float sum = 0.f;
#pragma unroll
        for (int kb = 0; kb < 10; ++kb)
#pragma unroll
            for (int r = 0; r < 4; ++r) { const float pv = s[kb][r] > -1e29f ? __expf(s[kb][r] - m) : 0.f; s[kb][r] = pv; sum += pv; }
        sum += __shfl_xor(sum, 16); sum += __shfl_xor(sum, 32);
        const float inv = 1.0f / (sum + __expf(sink - m));
        f32x4 o[4];
#pragma unroll
        for (int c4 = 0; c4 < 4; ++c4) o[c4] = (f32x4){0.f, 0.f, 0.f, 0.f};
#pragma unroll
        for (int k2 = 0; k2 < 5; ++k2) {
            const int kbase = 32 * k2;
            const f32x4 a = s[2 * k2], cc = s[2 * k2 + 1]; u32x4 pw; pw.x = pk2(a[0], a[1]); pw.y = pk2(a[2], a[3]); pw.z = pk2(cc[0], cc[1]); pw.w = pk2(cc[2], cc[3]);
            const bf16x8 y = __builtin_bit_cast(bf16x8, pw);
#pragma unroll
            for (int db = 0; db < 4; ++db) { const LAS bf16_t* ap = VS + (kbase + 4 * g + (li >> 2)) * KS_P + 16 * (li & 3) + 4 * db; const bf16x8 x = cat8(vtr(ap), vtr(ap + 16 * KS_P));
                o[db] = MFMA16(x, y, o[db]); }
        }
        const f32x4 v0 = o[0] * inv, v1 = o[1] * inv, v2 = o[2] * inv, v3 = o[3] * inv; const size_t ro = rq + 16 * g;
        *(u32x4*)(OG + ro) = (u32x4){pk2(v0[0] * bflo(g0.x), v0[1] * bfhi(g0.x)), pk2(v0[2] * bflo(g0.y), v0[3] * bfhi(g0.y)), pk2(v1[0] * bflo(g0.z), v1[1] * bfhi(g0.z)), pk2(v1[2] * bflo(g0.w), v1[3] * bfhi(g0.w))};
        *(u32x4*)(OG + ro + 8) = (u32x4){pk2(v2[0] * bflo(g1.x), v2[1] * bfhi(g1.x)), pk2(v2[2] * bflo(g1.y), v2[3] * bfhi(g1.y)), pk2(v3[0] * bflo(g1.z), v3[1] * bfhi(g1.z)), pk2(v3[2] * bflo(g1.w), v3[3] * bfhi(g1.w))};
    }
}

__device__ __forceinline__ void phase_final(const Params& p, int lane, int gw, int NGW) {
    const bf16_t* XB = (const bf16_t*)(p.ws + WS_XB); const float* nf = p.in[I_NORM_F];
    for (int rr = gw; rr < 8192 + 128; rr += NGW) {
        const int r = rr < 8192 ? rr : ROW_SAMP + (rr - 8192);
        float* dst = rr < 8192 ? p.out + O_YP + (size_t)rr * DM : p.out + O_YS + (size_t)(rr - 8192) * DM;
        u32x4 raw[4]; float ss = 0.f;
#pragma unroll
        for (int j = 0; j < 4; ++j) { raw[j] = ((const u32x4*)(XB + (size_t)r * DM))[lane + 64 * j];
            const float a0 = bflo(raw[j].x), a1 = bfhi(raw[j].x), a2 = bflo(raw[j].y), a3 = bfhi(raw[j].y), a4 = bflo(raw[j].z), a5 = bfhi(raw[j].z), a6 = bflo(raw[j].w), a7 = bfhi(raw[j].w);
            ss += (a0 * a0 + a1 * a1) + (a2 * a2 + a3 * a3) + (a4 * a4 + a5 * a5) + (a6 * a6 + a7 * a7); }
        const float rinv = rsqrtf(wave_sum(ss) * (1.0f / DM) + EPS);
#pragma unroll
        for (int j = 0; j < 4; ++j) { const int c = 8 * (lane + 64 * j); const f32x4 g0 = *(const f32x4*)(nf + c), g1 = *(const f32x4*)(nf + c + 4);
            *(f32x4*)(dst + c) = (f32x4){bflo(raw[j].x), bfhi(raw[j].x), bflo(raw[j].y), bfhi(raw[j].y)} * rinv * g0;
            *(f32x4*)(dst + c + 4) = (f32x4){bflo(raw[j].z), bfhi(raw[j].z), bflo(raw[j].w), bfhi(raw[j].w)} * rinv * g1; }
    }
}

#define XB_TMO      128
#define XB_XCNT(j)  (256  + 64 * (j))
#define XB_XSUB(j)  (1280 + 64 * (j))
#define XB_XGEN(j)  (2304 + 64 * (j))
#define XB_TOP      3328
#define XB_TOPGEN   3392
#define XCD_BAR_WORDS 3456
#define XB_SPIN_CAP (1u << 18)

__device__ __forceinline__ unsigned xb_ld(unsigned* p)              { return __hip_atomic_load(p, __ATOMIC_RELAXED, __HIP_MEMORY_SCOPE_AGENT); }
__device__ __forceinline__ unsigned xb_add(unsigned* p, unsigned v) { return __hip_atomic_fetch_add(p, v, __ATOMIC_RELAXED, __HIP_MEMORY_SCOPE_AGENT); }
__device__ __forceinline__ unsigned xb_xcc_id() { return (unsigned)__builtin_amdgcn_s_getreg((3 << 11) | 20) & 0xFu; }
#define XB_SPIN(cond, bar) do { unsigned _sp = 0; while (cond) { __builtin_amdgcn_s_sleep(1); \
    if ((++_sp & 255u) == 0u) { if (xb_ld(&(bar)[XB_TMO])) break; if (_sp > XB_SPIN_CAP) { atomicAdd(&(bar)[XB_TMO], 1u); break; } } } } while (0)

struct XcdBarrier {
    unsigned* bar; unsigned x;
    volatile LAS unsigned* st;
};

__device__ __forceinline__ XcdBarrier xcd_barrier_post(unsigned* bar, volatile LAS unsigned* st) {
    XcdBarrier b; b.bar = bar; b.x = xb_xcc_id(); b.st = st;
    if (threadIdx.x == 0) (void)xb_add(&bar[XB_XCNT(b.x)], 1u);
    return b;
}
__device__ __forceinline__ void xcd_barrier_complete(unsigned* bar, unsigned x, unsigned& nloc, unsigned& nx) {
    const unsigned G = gridDim.x * gridDim.y * gridDim.z;
    unsigned sum, cnt, mine, sp = 0u;
    for (;;) {
        sum = 0u; cnt = 0u; mine = 0u;
#pragma unroll
        for (unsigned j = 0; j < 16; ++j) { const unsigned c = xb_ld(&bar[XB_XCNT(j)]); sum += c; cnt += (c > 0u) ? 1u : 0u; mine = (j == x) ? c : mine; }
        if (sum == G) break;
        __builtin_amdgcn_s_sleep(1);
        if ((++sp & 255u) == 0u) { if (xb_ld(&bar[XB_TMO])) break; if (sp > XB_SPIN_CAP) { atomicAdd(&bar[XB_TMO], 1u); break; } }
    }
    nloc = mine > 0u ? mine : 1u; nx = cnt > 0u ? cnt : 1u;
}

__device__ __forceinline__ void xcd_barrier(const XcdBarrier& b) {
    asm volatile("s_waitcnt vmcnt(0)" ::: "memory");
    __syncthreads();
    if (threadIdx.x == 0) {
        unsigned* bar = b.bar;
        __builtin_amdgcn_s_waitcnt(0);
        unsigned nloc = b.st[0], nx = b.st[1];
        if (nloc == 0u) { xcd_barrier_complete(bar, b.x, nloc, nx); b.st[0] = nloc; b.st[1] = nx; }
        const unsigned old = xb_add(&bar[XB_XSUB(b.x)], 1u);
        const unsigned gen = old / nloc;
        if (old + 1u == (gen + 1u) * nloc) {
            __builtin_amdgcn_fence(__ATOMIC_RELEASE, "agent");
            asm volatile("s_waitcnt vmcnt(0)" ::: "memory");
            const unsigned og = xb_add(&bar[XB_TOP], 1u);
            const unsigned tg = og / nx;
            if (og + 1u == (tg + 1u) * nx) xb_add(&bar[XB_TOPGEN], 1u);
            else XB_SPIN(xb_ld(&bar[XB_TOPGEN]) == tg, bar);
            __builtin_amdgcn_fence(__ATOMIC_ACQUIRE, "agent");
            xb_add(&bar[XB_XGEN(b.x)], 1u);
            asm volatile("s_waitcnt vmcnt(0)" ::: "memory");
        } else {
            XB_SPIN(xb_ld(&bar[XB_XGEN(b.x)]) == gen, bar);
            __builtin_amdgcn_fence(__ATOMIC_ACQUIRE, "agent");
            asm volatile("s_waitcnt vmcnt(0)" ::: "memory");
        }
    }
    __syncthreads();
}


constexpr int NPHASE = 18;
#ifndef DUP_MASK
#define DUP_MASK 0
#endif
#define REP(bit) for (int rep_ = 0; rep_ < 1 + ((DUP_MASK >> (bit)) & 1); ++rep_)
__device__ __forceinline__ int launder_i(int x) { asm volatile("" : "+v"(x)); return x; }
template <class T> __device__ __forceinline__ T* launder_p(T* x) { size_t z = 0; asm volatile("" : "+s"(z)); return (T*)((char*)x + z); }
__global__ void __launch_bounds__(NTHR, 2) yoco_fwd(Params p) {
    extern __shared__ __attribute__((aligned(16))) unsigned char lds_raw[];
    LAS unsigned char* lds = (LAS unsigned char*)lds_raw;
    cg::grid_group grid = cg::this_grid();
    if (threadIdx.x < 4) ((volatile LAS unsigned*)(lds + LDS_BYTES - 16))[threadIdx.x] = 0u;
    __syncthreads();
    XcdBarrier xbar = xcd_barrier_post((unsigned*)(p.ws + WS_CTL), (volatile LAS unsigned*)(lds + LDS_BYTES - 16));
    const int bid = blockIdx.x, G = gridDim.x;
    const int lo = p.ph_lo, hi = p.ph_hi;
#define IN(k) (lo <= (k) && (k) < hi)
#define SEAM(k) do { if (IN(k) && IN((k) + 1)) { xcd_barrier(xbar); if (DUP_MASK & 512) { xcd_barrier(xbar); xcd_barrier(xbar); } } } while (0)
#define PHASE_VIEW() const int tid = launder_i(threadIdx.x); const int lane = tid & 63; const int wave = __builtin_amdgcn_readfirstlane(tid >> 6); (void)lane; (void)wave; \
    unsigned char* ws = launder_p(p.ws); float* X = (float*)(ws + WS_X); bf16_t* XB = (bf16_t*)(ws + WS_XB); float* SSQ = (float*)(ws + WS_SSQ); float* GLR = (float*)(ws + WS_GLR); \
    bf16_t* R1 = (bf16_t*)(ws + WS_R1); bf16_t* R2 = (bf16_t*)(ws + WS_R2); bf16_t* SG = (bf16_t*)(ws + WS_SG); bf16_t* OG = (bf16_t*)(ws + WS_OG); \
    bf16_t* QA = R1; bf16_t* KA = R1 + (size_t)MP * 1024; bf16_t* VA = R2; bf16_t* KVB = R1; bf16_t* QB = R2; \
    float* DEC = (float*)(ws + WS_DEC); bf16_t* DSM = (bf16_t*)(ws + WS_DSM); float* ORAW = (float*)(ws + WS_ORAW); bf16_t* DS = (bf16_t*)(ws + WS_DS); \
    (void)X; (void)XB; (void)SSQ; (void)GLR; (void)SG; (void)OG; (void)QA; (void)KA; (void)VA; (void)KVB; (void)QB; (void)DEC; (void)DSM; (void)ORAW; (void)DS;

    if (IN(0)) REP(0) { PHASE_VIEW(); phase_p0(p, lds, tid, lane, wave, bid, G); }
    SEAM(0);
#pragma unroll 1
    for (int l = 0; l < 2; ++l) {
        const int pb = 1 + 5 * l;
        if (IN(pb)) REP(1) { PHASE_VIEW();
            const bf16_t* wt = (const bf16_t*)(ws + WS_WTA_IN + l * WTA_IN_SZ);
            pg8::Gemm g{XB, wt, 8192, 6144, DM}; pg8::StaticOrder S; S.init(8192, 6144, G, bid);
            pg8::EpiGlaIn E{SSQ, QA, KA, VA, SG, GLR};
            pg8::gemm_phase<pg8::EpiGlaIn, pg8::StaticOrder, true, true>(lds, g, S, E);
#pragma unroll 1
            for (int u = G - 1 - bid; u < 2 * 97; u += G) tail_gemm_unit(lds, launder_i(threadIdx.x), XB, wt, 64 * (u >> 1), u & 1, E);
#pragma unroll 1
            for (int u = bid; u < 256; u += G) glr_unit(lds, launder_i(threadIdx.x), XB, wt, u, SSQ, GLR);
            { const int t2 = launder_i(threadIdx.x); slot_convert(p, lds, CV_OA + l * CV_SQ, CV_SQ, G > 194 ? G - 194 : 0, t2 & 63, __builtin_amdgcn_readfirstlane(t2 >> 6), bid); }
        }
        SEAM(pb);
        if (IN(pb + 1)) REP(2) { PHASE_VIEW();
            const float* wg = p.in[I_WGK2] + (size_t)l * 16 * 1024; const float* bg = p.in[I_BGK2] + (size_t)l * 1024;
            { const float* onorm_s = p.in[I_ONORM] + (size_t)l * 512; const int half = G / 2 > 0 ? G / 2 : 1;
#pragma unroll 1
              for (int u = bid - (G - half); u < 128; u += half) { if (u < 0) break; const int tid = launder_i(threadIdx.x); const int bs = u >> 2, hh = u & 3; const size_t so = ((size_t)((l * 32 + bs) * 4 + hh) * 256) * 512;
                  gla_tile_sample_full(lds, tid, bs, hh, GLR, wg, bg, QA, KA, VA, p.in[I_SGLA] + so, p.out + O_SS + so, onorm_s, SG, OG); } }
#pragma unroll 1
            for (int t0 = bid; t0 < 512 + 4 + 4; t0 += G) { const int tid = launder_i(threadIdx.x); const int t = t0 + 256;
                if (t0 >= 516) gla_tile_c(lds, tid, ROW_META, 16, t0 - 516, GLR, wg, bg, QA, KA, VA, nullptr, p.in[I_ONORM] + (size_t)l * 512, SG, OG);
                else { int row0, ntok, h; bf16_t* dso; float* deco;
                    if (t < 768) { const int u = t - 256, b = u >> 8, c = (u >> 2) & 63; h = u & 3; row0 = b * 4096 + c * 64; ntok = 64;
                        dso = DS + ((size_t)((b * 64 + c) * 4 + h) * 512) * 256; deco = DEC + (size_t)((b * 64 + c) * 4 + h) * 256; }
                    else { h = t - 768; row0 = ROW_META; ntok = 16; dso = DSM + (size_t)h * 512 * 256; deco = nullptr; }
                    REP(11) gla_tile_a(lds, tid, row0, ntok, h, GLR, wg, bg, KA, VA, dso, deco); }
            }
        }
        SEAM(pb + 1);
        if (IN(pb + 2)) { PHASE_VIEW(); gla_scan(lds, tid, bid, G, DS, DSM, DEC, p.out + O_SP + (size_t)l * 2 * 4 * 256 * 512); }
        SEAM(pb + 2);
        if (IN(pb + 3)) REP(4) { PHASE_VIEW();
            const float* wg = p.in[I_WGK2] + (size_t)l * 16 * 1024; const float* bg = p.in[I_BGK2] + (size_t)l * 1024; const float* onorm = p.in[I_ONORM] + (size_t)l * 512;
#pragma unroll 1
            for (int t = bid; t < 512; t += G) { const int tid = launder_i(threadIdx.x);
                { const int b = t >> 8, c = (t >> 2) & 63, h = t & 3;
                    gla_tile_c(lds, tid, b * 4096 + c * 64, 64, h, GLR, wg, bg, QA, KA, VA, DS + ((size_t)((b * 64 + c) * 4 + h) * 512) * 256, onorm, SG, OG); }

            }
        }
        SEAM(pb + 3);
        if (IN(pb + 4)) { PHASE_VIEW();
            const bf16_t* wt = (const bf16_t*)(ws + WS_WTA_OUT + l * WT_SQ_SZ);
            pg8::Gemm g{OG, wt, 8192, DM, DM}; pg8::StaticOrder S; S.init(8192, DM, G, bid);
            pg8::EpiOut E{X, XB, SSQ};
            pg8::gemm_phase<pg8::EpiOut, pg8::StaticOrder, true, true>(lds, g, S, E);
#pragma unroll 1
            for (int u = G - 1 - bid; u < 64; u += G) tail_gemm_unit(lds, launder_i(threadIdx.x), OG, wt, 64 * (u >> 1), u & 1, E);
            { const int t2 = launder_i(threadIdx.x); const int ln2 = t2 & 63, wv2 = __builtin_amdgcn_readfirstlane(t2 >> 6);
              slot_convert(p, lds, l == 0 ? CV_INA : CV_OB0, l == 0 ? CV_INA : CV_SQ + CV_KV + CV_INB, G > 194 ? G - 64 : 0, ln2, wv2, bid);
              if (l == 0 && G > 194 && bid < G - 64) cache_copy(p, bid * NTHR + t2, (G - 64) * NTHR); }
        }
        SEAM(pb + 4);
    }
#pragma unroll 1
    for (int j = 0; j < 2; ++j) {
        const int pb = 11 + 3 * j;
        if (IN(pb)) REP(6) { PHASE_VIEW(); const int kvt = j == 0 ? 4 : 0; const int N = j == 0 ? 5120 : 4096;
            const bf16_t* wt = (const bf16_t*)(ws + (j == 0 ? WS_WTB0 : WS_WTB1));
            pg8::Gemm g{XB, wt, 8192, N, DM}; pg8::StaticOrder S; S.init(8192, N, G, bid);
            pg8::EpiSwaIn E{SSQ, KVB, QB, SG, p.out, kvt};
            pg8::gemm_phase<pg8::EpiSwaIn, pg8::StaticOrder, true, true>(lds, g, S, E);
#pragma unroll 1
            for (int u = (j == 0 ? (bid >= G / 2 ? G - 1 - bid : 1 << 20) : G - 1 - bid); u < N / 32; u += (j == 0 ? G / 2 : G)) tail_gemm_unit(lds, launder_i(threadIdx.x), XB, wt, 64 * (u >> 1), u & 1, E);
            if (j == 1) { const int t2 = launder_i(threadIdx.x); slot_convert(p, lds, CV_OB1, CV_SQ, G > 194 ? G - 128 : 0, t2 & 63, __builtin_amdgcn_readfirstlane(t2 >> 6), bid); }
        }
        SEAM(pb);
        if (IN(pb + 1)) REP(7) { PHASE_VIEW(); const float* sinks = p.in[I_SINKS] + j * 32;
#pragma unroll 1
            for (int t = bid; t < 256 + 512 + 8; t += G) { const int tid = launder_i(threadIdx.x);
                if (t < 256) REP(12) swa_decode_tile(lds, tid, t >> 3, t & 7, p.in[I_CK], p.in[I_CV], KVB, QB, SG, sinks, OG);
                else { int b, tq0, kvh, nq;
                    if (t < 768) { const int u = t - 256; b = u >> 8; tq0 = 128 * ((u >> 3) & 31); kvh = u & 7; nq = 128; }
                    else { b = 0; tq0 = -16; kvh = t - 768; nq = 16; }
                    REP(13) swa_tile(lds, tid, b, tq0, kvh, nq, KVB, QB, SG, sinks, OG); }
            }
        }
        SEAM(pb + 1);
        if (IN(pb + 2)) { PHASE_VIEW();
            const bf16_t* wt = (const bf16_t*)(ws + WS_WTB_OUT + j * WT_SQ_SZ);
            pg8::Gemm g{OG, wt, 8192, DM, DM}; pg8::StaticOrder S; S.init(8192, DM, G, bid);
            pg8::EpiOut E{X, XB, SSQ};
            pg8::gemm_phase<pg8::EpiOut, pg8::StaticOrder, true, true>(lds, g, S, E);
#pragma unroll 1
            for (int u = G - 1 - bid; u < 64; u += G) tail_gemm_unit(lds, launder_i(threadIdx.x), OG, wt, 64 * (u >> 1), u & 1, E);
            if (j == 0) { const int t2 = launder_i(threadIdx.x); slot_convert(p, lds, CV_IB1, CV_INB, G > 194 ? G - 64 : 0, t2 & 63, __builtin_amdgcn_readfirstlane(t2 >> 6), bid); }
        }
        SEAM(pb + 2);
    }
    if (IN(17)) REP(8) { PHASE_VIEW(); phase_final(p, lane, bid * 8 + wave, G * 8); }
    if (hi == -12345) grid.sync();
#undef IN
#undef SEAM
#undef PHASE_VIEW
}

#ifndef N_LAUNCH_MODE
#define N_LAUNCH_MODE 1
#endif
extern "C" void kernel_launch(void* const* d_in, const int* in_sizes, int n_in, void* d_out, int out_size, void* d_ws, size_t ws_size, hipStream_t stream) {
    static int grid = 0;
    if (grid == 0) {
        if (n_in != 19 || ws_size < WS_END) { fprintf(stderr, "kernel_launch: unexpected inputs (n_in %d, ws %zu < %zu)\n", n_in, ws_size, (size_t)WS_END); grid = -1; return; }
        int dev = 0, cus = 0, per_cu = 0;
        (void)hipGetDevice(&dev); (void)hipDeviceGetAttribute(&cus, hipDeviceAttributeMultiprocessorCount, dev);
        if (hipFuncSetAttribute((const void*)yoco_fwd, hipFuncAttributeMaxDynamicSharedMemorySize, LDS_BYTES) != hipSuccess) { fprintf(stderr, "kernel_launch: hipFuncSetAttribute failed\n"); grid = -1; return; }
        if (hipOccupancyMaxActiveBlocksPerMultiprocessor(&per_cu, (const void*)yoco_fwd, NTHR, LDS_BYTES) != hipSuccess || per_cu < 1) { fprintf(stderr, "kernel_launch: occupancy query says %d\n", per_cu); per_cu = 1; }
        (void)hipGetLastError();
        grid = cus > 0 ? cus : 256;
    }
    if (grid < 0) return;
    if (hipMemsetAsync((char*)d_ws + WS_CTL, 0, CTL_BYTES, stream) != hipSuccess) { fprintf(stderr, "kernel_launch: memset failed\n"); return; }
    Params p{};
    for (int i = 0; i < 19; ++i) p.in[i] = (const float*)d_in[i];
    p.out = (float*)d_out; p.ws = (unsigned char*)d_ws;
#if N_LAUNCH_MODE == 1
    p.ph_lo = 0; p.ph_hi = NPHASE;
    void* args[] = {&p};
    hipError_t e = hipLaunchCooperativeKernel((const void*)yoco_fwd, dim3(grid), dim3(NTHR), args, LDS_BYTES, stream);
    if (e != hipSuccess) fprintf(stderr, "cooperative launch failed: %s (grid %d)\n", hipGetErrorString(e), grid);
#else
    for (int ph = 0; ph < NPHASE; ++ph) { p.ph_lo = ph; p.ph_hi = ph + 1; hipLaunchKernelGGL(yoco_fwd, dim3(grid), dim3(NTHR), LDS_BYTES, stream, p); }
#endif
}
```

```cpp
#include <hip/hip_runtime.h>
#include <hip/hip_cooperative_groups.h>
#include <cstdio>
#include <cstdint>
namespace cg = cooperative_groups;
namespace pg8 {
#define PG8_LAS __attribute__((address_space(3)))
typedef unsigned short bf16_t;
typedef short bf16x8 __attribute__((ext_vector_type(8)));
typedef float f32x4 __attribute__((ext_vector_type(4)));
typedef unsigned u32x4 __attribute__((ext_vector_type(4)));
constexpr int BM = 256, BK = 64, HALF = 128, HTB = HALF * BK * 2  , STAGE_BYTES = 8 * HTB, NXCD = 8, WGM = 8;

__host__ __device__ __forceinline__ int lds_byte(int r, int c) { const int st = (r >> 4) * 2 + (c >> 5), rr = r & 15, cc = c & 31, ob = rr * 64 + cc * 2; return st * 1024 + (ob ^ (((ob >> 9) & 1) << 5)); }
__host__ __device__ __forceinline__ void stage_rc(int b, int& R, int& C) { const int st = b / 1024, sb = b % 1024, swz = sb ^ (((sb >> 9) & 1) << 5); R = (st >> 1) * 16 + swz / 64; C = (st & 1) * 32 + (swz % 64) / 2; }
__host__ __device__ __forceinline__ int perm32(int rho) { const int n = rho >> 4, i = rho & 15; return 8 * (i >> 2) + 4 * n + (i & 3); }

struct Unit { int pm, pn; };
struct Gemm { const bf16_t* A; const bf16_t* Bt; int M, N, K; };

struct StaticOrder {
    int nM, nN, nwg, G, c;
    __host__ __device__ void init(int M, int N, int G_, int c_) { nM = M / BM; nN = N / BM; nwg = nM * nN; G = G_; c = c_; }
    __host__ __device__ bool next(int i, Unit& u) const {
        const long L = (long)i * G + c; if (L >= nwg) return false;
        int wgid = (int)L; { const int q = nwg / NXCD, r = nwg % NXCD, xcd = wgid % NXCD, off = wgid / NXCD; wgid = (xcd < r ? xcd * (q + 1) : r * (q + 1) + (xcd - r) * q) + off; }
        const int nig = WGM * nN, gid = wgid / nig, fm = gid * WGM, gsz = (nM - fm) < WGM ? (nM - fm) : WGM;
        u.pm = fm + ((wgid % nig) % gsz); u.pn = (wgid % nig) / gsz; return true;
    }
    __device__ __forceinline__ void a_ready(const Unit&) const {}
    __device__ __forceinline__ void done(const Unit&) const {}
};
__device__ __forceinline__ unsigned cvt_pk_bf16(float lo, float hi) { unsigned r; asm volatile("v_cvt_pk_bf16_f32 %0, %1, %2" : "=v"(r) : "v"(lo), "v"(hi)); return r; }
template <class Epi, class Sched, bool ALIGN_EPI = false, bool SP2 = false>
__device__ __forceinline__ void gemm_phase(PG8_LAS unsigned char* lds, const Gemm g, const Sched& S, const Epi& E) {
    int tid_l = threadIdx.x; asm volatile("" : "+v"(tid_l)); const int tid = tid_l, wid = __builtin_amdgcn_readfirstlane(tid >> 6), lane = tid & 63, wr = wid >> 2, wc = wid & 3, fr = lane & 15, fq = lane >> 4;
    const int K = g.K, nt = K / BK;
    unsigned voffA[2], voffB[2];
#pragma unroll
    for (int i = 0; i < 2; ++i) { int R, C; stage_rc(tid * 16 + i * 8192, R, C); const int Rb = Epi::PERM ? ((R & ~31) + perm32(R & 31)) : R;
        voffA[i] = (unsigned)(R * K + C) * 2u; voffB[i] = (unsigned)(Rb * K + C) * 2u; }
    const size_t kstep = (size_t)(BK * 2);
    const size_t hstep = (size_t)HALF * K * 2;
    const size_t tstep = 2 * hstep;
    const unsigned ldsw = (unsigned)wid * 1024u;
    const int aoff = lds_byte(wr * 64 + fr, fq * 8), boff = lds_byte(wc * 32 + fr, fq * 8);
#define PG8_SA(b, h) (((b) * 2 + (h)) * HTB)
#define PG8_SB(b, h) ((4 + (b) * 2 + (h)) * HTB)
#define PG8_STAGE(bufoff, gbase, voff) do { _Pragma("unroll") for (int _i = 0; _i < 2; ++_i) \
        __builtin_amdgcn_global_load_lds((const unsigned*)((const char*)(gbase) + (voff)[_i]), (PG8_LAS unsigned*)(lds + (bufoff) + ldsw + _i * 8192), 16, 0, 0); } while (0)
#define PG8_LDA(dst, b, h) do { _Pragma("unroll") for (int m = 0; m < 4; ++m) _Pragma("unroll") for (int k = 0; k < 2; ++k) dst[m][k] = *(const PG8_LAS bf16x8*)(lds + PG8_SA(b, h) + aoff + m * 2048 + k * 1024); } while (0)
#define PG8_LDB(dst, b, h) do { _Pragma("unroll") for (int n = 0; n < 2; ++n) _Pragma("unroll") for (int k = 0; k < 2; ++k) dst[n][k] = *(const PG8_LAS bf16x8*)(lds + PG8_SB(b, h) + boff + n * 2048 + k * 1024); } while (0)
#define PG8_MMA(ai, bj, At, Bt) do { __builtin_amdgcn_s_setprio(1); _Pragma("unroll") for (int m = 0; m < 4; ++m) _Pragma("unroll") for (int n = 0; n < 2; ++n) _Pragma("unroll") for (int k = 0; k < 2; ++k) \
        acc[ai][bj][m][n] = __builtin_amdgcn_mfma_f32_16x16x32_bf16(Bt[n][k], At[m][k], acc[ai][bj][m][n], 0, 0, 0); __builtin_amdgcn_s_setprio(0); } while (0)
#define PG8_WAIT_V(n) asm volatile("s_waitcnt vmcnt(" #n ")" ::: "memory")
#define PG8_WAIT_L(n) asm volatile("s_waitcnt lgkmcnt(" #n ")" ::: "memory")
#define PG8_BAR __builtin_amdgcn_s_barrier()
#define PG8_SCHED __builtin_amdgcn_sched_barrier(0)
    Unit cur, nxt; int ui = 0;
    if (!S.next(0, cur)) return;
    f32x4 acc[2][2][4][2];
#pragma unroll
    for (int a = 0; a < 2; ++a)
#pragma unroll
        for (int b = 0; b < 2; ++b)
#pragma unroll
            for (int m = 0; m < 4; ++m)
#pragma unroll
                for (int n = 0; n < 2; ++n) acc[a][b][m][n] = (f32x4){0.f, 0.f, 0.f, 0.f};
    bf16x8 At[4][2], B0[2][2], B1[2][2];
    const char* cA = (const char*)g.A + (size_t)cur.pm * tstep; const char* cB = (const char*)g.Bt + (size_t)cur.pn * tstep;
    S.a_ready(cur);
    if constexpr (SP2) {
        PG8_STAGE(PG8_SB(0, 0), cB, voffB); PG8_STAGE(PG8_SB(0, 1), cB + hstep, voffB); PG8_STAGE(PG8_SA(0, 0), cA, voffA); PG8_STAGE(PG8_SA(0, 1), cA + hstep, voffA);
        if (wr == 1) PG8_BAR;
        PG8_WAIT_V(2); PG8_BAR;
        PG8_STAGE(PG8_SB(1, 0), cB + kstep, voffB); PG8_STAGE(PG8_SA(1, 0), cA + kstep, voffA); PG8_STAGE(PG8_SB(1, 1), cB + hstep + kstep, voffB);
        PG8_WAIT_V(6); PG8_BAR;
    } else {
        PG8_STAGE(PG8_SB(0, 0), cB, voffB); PG8_STAGE(PG8_SA(0, 0), cA, voffA); PG8_STAGE(PG8_SB(0, 1), cB + hstep, voffB); PG8_STAGE(PG8_SA(0, 1), cA + hstep, voffA);
        if (wr == 1) PG8_BAR;
        PG8_WAIT_V(4); PG8_BAR;
        PG8_STAGE(PG8_SB(1, 0), cB + kstep, voffB); PG8_STAGE(PG8_SA(1, 0), cA + kstep, voffA); PG8_STAGE(PG8_SB(1, 1), cB + hstep + kstep, voffB);
        PG8_WAIT_V(6); PG8_BAR;
    }
    for (;;) {
        const bool has_next = S.next(ui + 1, nxt);
        const char* nA = has_next ? (const char*)g.A + (size_t)nxt.pm * tstep : cA; const char* nB = has_next ? (const char*)g.Bt + (size_t)nxt.pn * tstep : cB;
        for (int t = 0; t < nt; t += 2) {
            const bool last = (t == nt - 2);
            const char* a1 = cA + (size_t)(t + 1) * kstep;
            const char* a2 = last ? nA : cA + (size_t)(t + 2) * kstep; const char* b2 = last ? nB : cB + (size_t)(t + 2) * kstep;
            const char* a3 = a2 + kstep; const char* b3 = b2 + kstep;
            if (last && has_next) S.a_ready(nxt);
            if constexpr (SP2) {
            PG8_LDB(B0, 0, 0); PG8_LDB(B1, 0, 1); PG8_SCHED; PG8_LDA(At, 0, 0); PG8_STAGE(PG8_SA(1, 1), a1 + hstep, voffA);
            PG8_WAIT_V(8); PG8_WAIT_L(0); PG8_BAR; PG8_MMA(0, 0, At, B0); PG8_MMA(0, 1, At, B1); PG8_BAR; PG8_SCHED;
            PG8_LDA(At, 0, 1); PG8_STAGE(PG8_SB(0, 0), b2, voffB); PG8_STAGE(PG8_SB(0, 1), b2 + hstep, voffB); PG8_STAGE(PG8_SA(0, 0), a2, voffA);
            PG8_WAIT_V(8); PG8_WAIT_L(0); PG8_BAR; PG8_MMA(1, 0, At, B0); PG8_MMA(1, 1, At, B1); PG8_BAR; PG8_SCHED;
            PG8_LDB(B0, 1, 0); PG8_LDB(B1, 1, 1); PG8_SCHED; PG8_LDA(At, 1, 0); PG8_STAGE(PG8_SA(0, 1), a2 + hstep, voffA);
            PG8_WAIT_V(8); PG8_WAIT_L(0); PG8_BAR; PG8_MMA(0, 0, At, B0); PG8_MMA(0, 1, At, B1); PG8_BAR; PG8_SCHED;
            PG8_LDA(At, 1, 1); PG8_STAGE(PG8_SB(1, 0), b3, voffB); PG8_STAGE(PG8_SB(1, 1), b3 + hstep, voffB); PG8_STAGE(PG8_SA(1, 0), a3, voffA);
            PG8_WAIT_V(8); PG8_WAIT_L(0); PG8_BAR; PG8_MMA(1, 0, At, B0); PG8_MMA(1, 1, At, B1); PG8_BAR; PG8_SCHED;
            } else {
            PG8_LDB(B0, 0, 0); PG8_SCHED; PG8_LDA(At, 0, 0); PG8_STAGE(PG8_SA(1, 1), a1 + hstep, voffA);
            PG8_WAIT_L(8); PG8_BAR; PG8_WAIT_L(0); PG8_MMA(0, 0, At, B0); PG8_BAR; PG8_SCHED;
            PG8_LDB(B1, 0, 1); PG8_STAGE(PG8_SB(0, 0), b2, voffB);
            PG8_BAR; PG8_WAIT_L(0); PG8_MMA(0, 1, At, B1); PG8_BAR;
            PG8_LDA(At, 0, 1); PG8_STAGE(PG8_SA(0, 0), a2, voffA);
            PG8_BAR; PG8_WAIT_L(0); PG8_MMA(1, 0, At, B0); PG8_BAR; PG8_SCHED;
            PG8_STAGE(PG8_SB(0, 1), b2 + hstep, voffB);
            PG8_WAIT_V(6); PG8_BAR; PG8_MMA(1, 1, At, B1); PG8_BAR;
            PG8_LDB(B0, 1, 0); PG8_SCHED; PG8_LDA(At, 1, 0); PG8_STAGE(PG8_SA(0, 1), a2 + hstep, voffA);
            PG8_WAIT_L(8); PG8_BAR; PG8_WAIT_L(0); PG8_MMA(0, 0, At, B0); PG8_BAR; PG8_SCHED;
            PG8_LDB(B1, 1, 1); PG8_STAGE(PG8_SB(1, 0), b3, voffB);
            PG8_BAR; PG8_WAIT_L(0); PG8_MMA(0, 1, At, B1); PG8_BAR;
            PG8_LDA(At, 1, 1); PG8_STAGE(PG8_SA(1, 0), a3, voffA);
            PG8_BAR; PG8_WAIT_L(0); PG8_MMA(1, 0, At, B0); PG8_BAR; PG8_SCHED;
            PG8_STAGE(PG8_SB(1, 1), b3 + hstep, voffB);
            PG8_WAIT_V(6); PG8_BAR; PG8_MMA(1, 1, At, B1); PG8_BAR;
            }
        }
        if constexpr (ALIGN_EPI) { if (wr == 0) PG8_BAR; }
        if constexpr (!Epi::AFTER_DRAIN) { E(acc, cur, wr, wc, fr, fq); S.done(cur); }
        if (!has_next) break;
#pragma unroll
        for (int a = 0; a < 2; ++a)
#pragma unroll
            for (int b = 0; b < 2; ++b)
#pragma unroll
                for (int m = 0; m < 4; ++m)
#pragma unroll
                    for (int n = 0; n < 2; ++n) acc[a][b][m][n] = (f32x4){0.f, 0.f, 0.f, 0.f};
        cur = nxt; cA = nA; cB = nB; ++ui;
        if constexpr (ALIGN_EPI) { if (wr == 1) PG8_BAR; }
    }
    PG8_WAIT_V(0);
    if constexpr (!ALIGN_EPI) { if (wr == 0) PG8_BAR; }
    PG8_BAR;
    if constexpr (Epi::AFTER_DRAIN) { E.fused(acc, cur, wr, wc, fr, fq, lds, wid, lane); S.done(cur); }
#undef PG8_SA
#undef PG8_SB
#undef PG8_STAGE
#undef PG8_LDA
#undef PG8_LDB
#undef PG8_MMA
#undef PG8_WAIT_V
#undef PG8_WAIT_L
#undef PG8_BAR
#undef PG8_SCHED
}
}
#define LAS __attribute__((address_space(3)))
typedef unsigned short bf16_t;
typedef short bf16x8 __attribute__((ext_vector_type(8)));
typedef short s16x4 __attribute__((ext_vector_type(4)));
typedef float f32x4 __attribute__((ext_vector_type(4)));
typedef unsigned u32x4 __attribute__((ext_vector_type(4)));
typedef unsigned u32x2 __attribute__((ext_vector_type(2)));

constexpr int DM = 2048, MP = 8448, ROW_META = 8192, ROW_SAMP = 8208, ROW_END = 8336;
constexpr int NA_IN = 6160, NA_PAD = 6400;
constexpr float EPS = 1e-6f;
constexpr size_t WS_WTA_IN = 0, WTA_IN_SZ = (size_t)NA_PAD * DM * 2;
constexpr size_t WS_WTA_OUT = WS_WTA_IN + 2 * WTA_IN_SZ, WT_SQ_SZ = (size_t)DM * DM * 2;
constexpr size_t WS_WTB0 = WS_WTA_OUT + 2 * WT_SQ_SZ;
constexpr size_t WS_WTB1 = WS_WTB0 + (size_t)5120 * DM * 2;
constexpr size_t WS_WTB_OUT = WS_WTB1 + (size_t)4096 * DM * 2;
constexpr size_t WS_X = WS_WTB_OUT + 2 * WT_SQ_SZ;
constexpr size_t WS_XB = WS_X + (size_t)MP * DM * 4;
constexpr size_t ACT_SZ = (size_t)MP * DM * 2;
constexpr size_t WS_R1 = WS_XB + ACT_SZ;
constexpr size_t WS_R2 = WS_R1 + ACT_SZ;
constexpr size_t WS_SG = WS_R2 + ACT_SZ;
constexpr size_t WS_OG = WS_SG + ACT_SZ;
constexpr size_t WS_SSQ = WS_OG + ACT_SZ;
constexpr size_t WS_GLR = WS_SSQ + (size_t)MP * 32 * 4;
constexpr size_t WS_DEC = WS_GLR + (size_t)MP * 16 * 4;
constexpr size_t WS_DSM = WS_DEC + (size_t)2 * 64 * 4 * 256 * 4;
constexpr size_t WS_ORAW = WS_DSM + (size_t)4 * 512 * 256 * 2;
constexpr size_t WS_DS = WS_ORAW + (size_t)32 * 4 * 4 * 512 * 4;
constexpr size_t WS_CTL = WS_DS + (size_t)2 * 64 * 4 * 512 * 256 * 2, CTL_BYTES = 65536;
constexpr size_t WS_END = WS_CTL + CTL_BYTES;
constexpr size_t O_YP = 0, O_YS = 16777216, O_SP = O_YS + 262144, O_SS = O_SP + 2097152, O_KWP = O_SS + 33554432,
                 O_VWP = O_KWP + 131072, O_KWS = O_VWP + 131072, O_VWS = O_KWS + 2097152;
constexpr int LDS_BYTES = 147456;
constexpr int NTHR = 512;

struct Params { const float* in[19]; float* out; unsigned char* ws; int ph_lo, ph_hi; };
enum { I_XP = 0, I_XS, I_SGLA, I_CK, I_CV, I_META, I_NORM_A, I_WIN_A, I_WGK2, I_BGK2, I_ONORM, I_WOUT_A, I_NORM_KV, I_WKV, I_NORM_B, I_WIN_B, I_SINKS, I_WOUT_B, I_NORM_F };

__device__ __forceinline__ unsigned f2bf(float f) { unsigned u = __builtin_bit_cast(unsigned, f); return (u + 0x7fffu + ((u >> 16) & 1u)) >> 16; }
typedef float f32x2_t __attribute__((ext_vector_type(2))); typedef __bf16 bf16x2_t __attribute__((ext_vector_type(2)));
__device__ __forceinline__ unsigned pk2(float lo, float hi) { const f32x2_t v = {lo, hi}; const bf16x2_t b = __builtin_convertvector(v, bf16x2_t); return __builtin_bit_cast(unsigned, b); }
__device__ __forceinline__ float bf2f(unsigned h) { return __builtin_bit_cast(float, h << 16); }
__device__ __forceinline__ float bflo(unsigned w) { return __builtin_bit_cast(float, w << 16); }
__device__ __forceinline__ float bfhi(unsigned w) { return __builtin_bit_cast(float, w & 0xffff0000u); }
__device__ __forceinline__ float wave_sum(float v) {
#pragma unroll
    for (int o = 1; o < 64; o <<= 1) v += __shfl_xor(v, o);
    return v;
}
__device__ __forceinline__ float wave_max(float v) {
#pragma unroll
    for (int o = 1; o < 64; o <<= 1) v = fmaxf(v, __shfl_xor(v, o));
    return v;
}
__device__ __forceinline__ float silu_f(float x) { return x / (1.0f + __expf(-x)); }
__device__ __forceinline__ s16x4 vtr(const LAS bf16_t* p) {
    typedef short v4i16_t __attribute__((ext_vector_type(4)));
    return __builtin_bit_cast(s16x4, __builtin_amdgcn_ds_read_tr16_b64_v4i16((LAS v4i16_t*)p));
}
__device__ __forceinline__ bf16x8 cat8(s16x4 a, s16x4 b) { return (bf16x8){a[0], a[1], a[2], a[3], b[0], b[1], b[2], b[3]}; }
#define MFMA16(a, b, c) __builtin_amdgcn_mfma_f32_16x16x32_bf16((a), (b), (c), 0, 0, 0)

namespace pg8 {
__device__ __forceinline__ float row_rinv(const float* ssq, int row) {
    const f32x4* p = (const f32x4*)(ssq + (size_t)row * 32); float s = 0.f;
#pragma unroll
    for (int i = 0; i < 8; ++i) { const f32x4 v = p[i]; s += (v[0] + v[1]) + (v[2] + v[3]); }
    return rsqrtf(s * (1.0f / DM) + EPS);
}
__device__ __forceinline__ u32x4 pack8(f32x4 a, f32x4 b) { u32x4 w; w.x = pk2(a[0], a[1]); w.y = pk2(a[2], a[3]); w.z = pk2(b[0], b[1]); w.w = pk2(b[2], b[3]); return w; }
__device__ __forceinline__ f32x4 silu4(f32x4 a) { return (f32x4){silu_f(a[0]), silu_f(a[1]), silu_f(a[2]), silu_f(a[3])}; }

struct EpiGlaIn {
    static constexpr bool PERM = true, AFTER_DRAIN = false;
    const float* ssq; bf16_t* Q; bf16_t* K; bf16_t* V; bf16_t* SG; float* GLR;
    __device__ __forceinline__ void store8(int row, int col, f32x4 v0, f32x4 v1) const {
        const int pn = col >> 8;
        if (pn < 4) *(u32x4*)(Q + (size_t)row * 1024 + col) = pack8(v0, v1);
        else if (pn < 8) *(u32x4*)(K + (size_t)row * 1024 + (col - 1024)) = pack8(v0, v1);
        else if (pn < 16) *(u32x4*)(V + (size_t)row * 2048 + (col - 2048)) = pack8(v0, v1);
        else if (pn < 24) *(u32x4*)(SG + (size_t)row * 2048 + (col - 4096)) = pack8(silu4(v0), silu4(v1));
        else if (col < NA_IN) { *(f32x4*)(GLR + (size_t)row * 16 + (col - 6144)) = v0; *(f32x4*)(GLR + (size_t)row * 16 + (col - 6144) + 4) = v1; }
    }
    __device__ __forceinline__ void operator()(const f32x4 (&acc)[2][2][4][2], const Unit& u, int wr, int wc, int fr, int fq) const {
        const int row0 = u.pm * BM + wr * 64 + fr; const int pn = u.pn;
#pragma unroll
        for (int ai = 0; ai < 2; ++ai)
#pragma unroll
            for (int m = 0; m < 4; ++m) {
                const int row = row0 + ai * HALF + m * 16; const float rs = row_rinv(ssq, row);
#pragma unroll
                for (int bj = 0; bj < 2; ++bj) store8(row, pn * BM + bj * HALF + wc * 32 + 8 * fq, acc[ai][bj][m][0] * rs, acc[ai][bj][m][1] * rs);
            }
    }
    __device__ __forceinline__ void tail16(int row, int col, f32x4 a0, f32x4 a1, f32x4 a2, f32x4 a3) const {
        const float rs = row_rinv(ssq, row); store8(row, col, a0 * rs, a1 * rs); store8(row, col + 8, a2 * rs, a3 * rs);
    }
};
struct EpiSwaIn {
    static constexpr bool PERM = true, AFTER_DRAIN = false;
    const float* ssq; bf16_t* KV; bf16_t* Q; bf16_t* SG; float* out; int kvt;
    __device__ __forceinline__ void store8(int row, int col, f32x4 v0, f32x4 v1) const {
        const int pn = col >> 8;
        if (pn < kvt) {
            *(u32x4*)(KV + (size_t)row * 1024 + col) = pack8(v0, v1);
            float* dst = nullptr; const int c5 = col & 511; const bool isv = col >= 512;
            if (row < ROW_META) { const int b = row >> 12, t = row & 4095; if (t >= 3968) dst = out + (isv ? O_VWP : O_KWP) + ((size_t)(b * 128 + t - 3968) * 512 + c5); }
            else if (row >= ROW_SAMP && row < ROW_END) { const int bs = (row - ROW_SAMP) >> 2, t = (row - ROW_SAMP) & 3; dst = out + (isv ? O_VWS : O_KWS) + ((size_t)(bs * 128 + 124 + t) * 512 + c5); }
            if (dst) { *(f32x4*)dst = v0; *(f32x4*)(dst + 4) = v1; }
        } else if (pn < kvt + 8) *(u32x4*)(Q + (size_t)row * 2048 + (col - kvt * 256)) = pack8(v0, v1);
        else *(u32x4*)(SG + (size_t)row * 2048 + (col - kvt * 256 - 2048)) = pack8(silu4(v0), silu4(v1));
    }
    __device__ __forceinline__ void operator()(const f32x4 (&acc)[2][2][4][2], const Unit& u, int wr, int wc, int fr, int fq) const {
        const int row0 = u.pm * BM + wr * 64 + fr; const int pn = u.pn;
#pragma unroll
        for (int ai = 0; ai < 2; ++ai)
#pragma unroll
            for (int m = 0; m < 4; ++m) {
                const int row = row0 + ai * HALF + m * 16; const float rs = row_rinv(ssq, row);
#pragma unroll
                for (int bj = 0; bj < 2; ++bj) store8(row, pn * BM + bj * HALF + wc * 32 + 8 * fq, acc[ai][bj][m][0] * rs, acc[ai][bj][m][1] * rs);
            }
    }
    __device__ __forceinline__ void tail16(int row, int col, f32x4 a0, f32x4 a1, f32x4 a2, f32x4 a3) const {
        const float rs = row_rinv(ssq, row); store8(row, col, a0 * rs, a1 * rs); store8(row, col + 8, a2 * rs, a3 * rs);
    }
};
struct EpiOut {
    static constexpr bool PERM = true, AFTER_DRAIN = false;
    float* X; bf16_t* XB; float* ssq;
    __device__ __forceinline__ float upd8(int row, int col, f32x4 a0, f32x4 a1) const {
        bf16_t* xp = XB + (size_t)row * DM + col; const u32x4 xo = *(const u32x4*)xp;
        const f32x4 v0 = (f32x4){bflo(xo.x), bfhi(xo.x), bflo(xo.y), bfhi(xo.y)} + a0, v1 = (f32x4){bflo(xo.z), bfhi(xo.z), bflo(xo.w), bfhi(xo.w)} + a1;
        const u32x4 w = pack8(v0, v1); *(u32x4*)xp = w;
        const f32x4 r0 = (f32x4){bflo(w.x), bfhi(w.x), bflo(w.y), bfhi(w.y)}, r1 = (f32x4){bflo(w.z), bfhi(w.z), bflo(w.w), bfhi(w.w)};
        return (r0[0] * r0[0] + r0[1] * r0[1]) + (r0[2] * r0[2] + r0[3] * r0[3]) + (r1[0] * r1[0] + r1[1] * r1[1]) + (r1[2] * r1[2] + r1[3] * r1[3]);
    }
    __device__ __forceinline__ void operator()(const f32x4 (&acc)[2][2][4][2], const Unit& u, int wr, int wc, int fr, int fq) const {
        const int row0 = u.pm * BM + wr * 64 + fr; const int pn = u.pn;
#pragma unroll
        for (int ai = 0; ai < 2; ++ai)
#pragma unroll
            for (int m = 0; m < 4; ++m) {
                const int row = row0 + ai * HALF + m * 16; float ss = 0.f;
#pragma unroll
                for (int bj = 0; bj < 2; ++bj) ss += upd8(row, pn * BM + bj * HALF + wc * 32 + 8 * fq, acc[ai][bj][m][0], acc[ai][bj][m][1]);
                ss += __shfl_xor(ss, 16); ss += __shfl_xor(ss, 32);
                if (fq == 0) ssq[(size_t)row * 32 + pn * 4 + wc] = ss;
            }
    }
    __device__ __forceinline__ void tail16(int row, int col, f32x4 a0, f32x4 a1, f32x4 a2, f32x4 a3) const {
        float ss = upd8(row, col, a0, a1) + upd8(row, col + 8, a2, a3);
        ss += __shfl_xor(ss, 16); ss += __shfl_xor(ss, 32);
        if ((threadIdx.x & 63) < 16) ssq[(size_t)row * 32 + (col >> 6)] = ss;
    }
};
}

__device__ __forceinline__ void transpose_item(const float* __restrict__ W, int K, int N, bf16_t* WT, int row_off, const float* __restrict__ gain, int qcols, float qscale,
                                               LAS float* scr, int item, int lane) {
    const int nblk = (N + 63) / 64, kb = item / nblk, nb = item % nblk, k0 = 64 * kb, n0 = 64 * nb;
    const int c4 = lane & 15, r = lane >> 4; const int nn = n0 + 4 * c4; const bool nv = nn < N;
    f32x4 v[16];
#pragma unroll
    for (int i = 0; i < 16; ++i) { const int kk = 4 * i + r; v[i] = nv ? __builtin_nontemporal_load((const f32x4*)(W + (size_t)(k0 + kk) * N + nn)) : (f32x4){0.f, 0.f, 0.f, 0.f}; }
#pragma unroll
    for (int i = 0; i < 16; ++i) { const int kk = 4 * i + r; const float gn = gain ? gain[k0 + kk] : 1.0f; LAS float* s = scr + kk * 65 + 4 * c4;
        s[0] = v[i][0] * gn; s[1] = v[i][1] * gn; s[2] = v[i][2] * gn; s[3] = v[i][3] * gn; }
    asm volatile("s_waitcnt lgkmcnt(0)" ::: "memory");
    const int c = lane & 7;
#pragma unroll
    for (int j = 0; j < 8; ++j) { const int n = (lane >> 3) + 8 * j; const LAS float* s = scr + (8 * c) * 65 + n;
        if (n0 + n < N) { const float cs = (n0 + n < qcols) ? qscale : 1.0f;
            u32x4 o; o.x = pk2(s[0 * 65] * cs, s[1 * 65] * cs); o.y = pk2(s[2 * 65] * cs, s[3 * 65] * cs); o.z = pk2(s[4 * 65] * cs, s[5 * 65] * cs); o.w = pk2(s[6 * 65] * cs, s[7 * 65] * cs);
            *(u32x4*)(WT + (size_t)(row_off + n0 + n) * K + k0 + 8 * c) = o; } }
    asm volatile("s_waitcnt lgkmcnt(0)" ::: "memory");
}

constexpr int CV_INA = 32 * 97, CV_SQ = 32 * 32, CV_KV = 32 * 16, CV_INB = 32 * 64;
constexpr int CV_NITEMS = 2 * CV_INA + 4 * CV_SQ + CV_KV + 2 * CV_INB;
constexpr int CV_OA = 2 * CV_INA, CV_OB0 = CV_OA + 2 * CV_SQ, CV_KVB = CV_OB0 + CV_SQ, CV_IB0 = CV_KVB + CV_KV, CV_IB1 = CV_IB0 + CV_INB, CV_OB1 = CV_IB1 + CV_INB;
static_assert(CV_OB1 + CV_SQ == CV_NITEMS, "item map");
__device__ __forceinline__ bool cv_moved(int it) { return it >= CV_INA; }
__device__ __forceinline__ void convert_any(const Params& p, int it, LAS float* scr, int lane) {
    unsigned char* ws = p.ws; int r = it;
    const float* W; int N; bf16_t* WT; int row_off = 0; const float* gain = nullptr; int qcols = 0; float qscale = 1.f;
    if (r < CV_OA) { const int l = r / CV_INA; r -= l * CV_INA; W = p.in[I_WIN_A] + (size_t)l * DM * NA_IN; N = NA_IN; WT = (bf16_t*)(ws + WS_WTA_IN + l * WTA_IN_SZ); gain = p.in[I_NORM_A] + l * DM; qcols = 1024; qscale = 0.0625f; }
    else if (r < CV_OB0) { r -= CV_OA; const int l = r / CV_SQ; r -= l * CV_SQ; W = p.in[I_WOUT_A] + (size_t)l * DM * DM; N = DM; WT = (bf16_t*)(ws + WS_WTA_OUT + l * WT_SQ_SZ); }
    else if (r < CV_KVB) { r -= CV_OB0; W = p.in[I_WOUT_B]; N = DM; WT = (bf16_t*)(ws + WS_WTB_OUT); }
    else if (r < CV_IB0) { r -= CV_KVB; W = p.in[I_WKV]; N = 1024; WT = (bf16_t*)(ws + WS_WTB0); gain = p.in[I_NORM_KV]; }
    else if (r < CV_IB1) { r -= CV_IB0; W = p.in[I_WIN_B]; N = 4096; WT = (bf16_t*)(ws + WS_WTB0); row_off = 1024; gain = p.in[I_NORM_B]; qcols = 2048; qscale = 0.125f; }
    else if (r < CV_OB1) { r -= CV_IB1; W = p.in[I_WIN_B] + (size_t)DM * 4096; N = 4096; WT = (bf16_t*)(ws + WS_WTB1); gain = p.in[I_NORM_B] + DM; qcols = 2048; qscale = 0.125f; }
    else { r -= CV_OB1; W = p.in[I_WOUT_B] + (size_t)DM * DM; N = DM; WT = (bf16_t*)(ws + WS_WTB_OUT + WT_SQ_SZ); }
    transpose_item(W, DM, N, WT, row_off, gain, qcols, qscale, scr, r, lane);
}
__device__ __forceinline__ void cache_copy(const Params& p, int gt, int NT) {
    constexpr int NC = 32 * 124 * 128;
    for (int i = gt; i < 2 * NC; i += NT) { const int kv = i / NC, r = i - kv * NC; const int bs = r / (124 * 128), r2 = r - bs * (124 * 128), j = r2 >> 7, c4 = r2 & 127;
        const f32x4 v = __builtin_nontemporal_load((const f32x4*)(p.in[kv ? I_CV : I_CK] + ((size_t)(bs * 128 + j + 4) * 512 + c4 * 4)));
        __builtin_nontemporal_store(v, (f32x4*)(p.out + (kv ? O_VWS : O_KWS) + ((size_t)(bs * 128 + j) * 512 + c4 * 4))); }
}
__device__ __forceinline__ void slot_convert(const Params& p, LAS unsigned char* lds, int it0, int n, int nidle, int lane, int wave, int bid) {
    if (nidle <= 0 || bid >= nidle) return;
    LAS float* scr = (LAS float*)(lds + wave * 16640);
    for (int k = bid * 8 + wave; k < n; k += nidle * 8) convert_any(p, it0 + k, scr, lane);
}

__device__ __forceinline__ void phase_p0(const Params& p, LAS unsigned char* lds, int tid, int lane, int wave, int bid, int G) {
    LAS float* scr = (LAS float*)(lds + wave * 16640);
    const int gw = bid * 8 + wave, NGW = G * 8;
    unsigned char* ws = p.ws;
    const bool moved_ok = G > 194;
    for (int it = gw; it < CV_NITEMS; it += NGW) { if (moved_ok && cv_moved(it)) continue; convert_any(p, it, scr, lane); }
    {
        const int gt = bid * NTHR + tid, NT = G * NTHR; constexpr int NZ = 240 * DM * 2 / 16;
        for (int i = gt; i < 2 * NZ; i += NT) { const int l = i / NZ, r = i - l * NZ;
            ((u32x4*)(ws + WS_WTA_IN + l * WTA_IN_SZ + (size_t)NA_IN * DM * 2))[r] = (u32x4){0u, 0u, 0u, 0u}; }
        if (!moved_ok) cache_copy(p, gt, NT);
    }
    bf16_t* XB = (bf16_t*)(ws + WS_XB); float* SSQ = (float*)(ws + WS_SSQ);
    for (int r = gw; r < MP; r += NGW) {
        const float* src = r < ROW_META ? p.in[I_XP] + (size_t)r * DM : r < ROW_SAMP ? p.in[I_META] + (size_t)(r - ROW_META) * DM : r < ROW_END ? p.in[I_XS] + (size_t)(r - ROW_SAMP) * DM : nullptr;
        f32x4 v[8]; float ss = 0.f;
#pragma unroll
        for (int j = 0; j < 8; ++j) v[j] = src ? __builtin_nontemporal_load((const f32x4*)src + lane + 64 * j) : (f32x4){0.f, 0.f, 0.f, 0.f};
#pragma unroll
        for (int j = 0; j < 8; ++j) { const unsigned w0 = pk2(v[j][0], v[j][1]), w1 = pk2(v[j][2], v[j][3]);
            ((u32x2*)(XB + (size_t)r * DM))[lane + 64 * j] = (u32x2){w0, w1};
            const float a0 = bflo(w0), a1 = bfhi(w0), a2 = bflo(w1), a3 = bfhi(w1); ss += (a0 * a0 + a1 * a1) + (a2 * a2 + a3 * a3); }
        ss = wave_sum(ss);
        if (lane < 32) SSQ[(size_t)r * 32 + lane] = lane == 0 ? ss : 0.f;
    }
}
constexpr int L_VS = 0, VS_P = 520;
constexpr int L_QT = 66560, QK_P = 264;
constexpr int L_KT = L_QT + 64 * QK_P * 2;
constexpr int L_KET = 66560, KET_P = 72;
constexpr int L_KRAW = L_KET + 256 * KET_P * 2;
constexpr int ATT_P = 72;
constexpr int L_GLR = 137216, L_HSUM = L_GLR + 4096, L_ROWSQ = L_HSUM + 2048;
static_assert(L_KRAW + 64 * QK_P * 2 <= L_GLR && L_KT + 64 * QK_P * 2 <= L_GLR && L_ROWSQ + 2048 <= LDS_BYTES - 16, "LDS map");

#define LDS_BAR() asm volatile("s_waitcnt lgkmcnt(0)\n\ts_barrier" ::: "memory")

__device__ __forceinline__ float gate_val(const LAS float* glr_row, const float (&w)[16], float bias) {
    float x = bias;
#pragma unroll
    for (int q4 = 0; q4 < 4; ++q4) { const f32x4 g = *(const LAS f32x4*)(glr_row + 4 * q4); x += g[0] * w[4 * q4] + g[1] * w[4 * q4 + 1] + g[2] * w[4 * q4 + 2] + g[3] * w[4 * q4 + 3]; }
    const float ls = fminf(x, 0.f) - __logf(1.0f + __expf(-fabsf(x)));
    return ls * 0.0625f;
}

template <int NC, int P>
__device__ __forceinline__ void stage_rows(LAS bf16_t* dst, int tid, const bf16_t* __restrict__ src, int ld, int row0, int ntok, int col0) {
#pragma unroll
    for (int i = 0; i < NC * 64 / NTHR; ++i) { const int chunk = tid + NTHR * i, j = chunk / NC, c = chunk % NC;
        u32x4 v = (u32x4){0u, 0u, 0u, 0u}; if (j < ntok) v = *(const u32x4*)(src + (size_t)(row0 + j) * ld + col0 + c * 8);
        *(LAS u32x4*)(dst + j * P + c * 8) = v; }
}
__device__ __forceinline__ void stage_glr(LAS unsigned char* lds, int tid, const float* __restrict__ GLR, int row0, int ntok) {
    if (tid < 256) { const int j = tid >> 2, r4 = tid & 3; f32x4 v = (f32x4){0.f, 0.f, 0.f, 0.f}; if (j < ntok) v = *(const f32x4*)(GLR + (size_t)(row0 + j) * 16 + r4 * 4); *(LAS f32x4*)((LAS float*)(lds + L_GLR) + j * 16 + r4 * 4) = v; }
}

template <int MODE>
__device__ __forceinline__ void gate_pass(LAS unsigned char* lds, int tid, int ntok, int h, const float* __restrict__ wg, const float* __restrict__ bg, float* dec_out) {
    LAS float* glrS = (LAS float*)(lds + L_GLR); LAS float* hsum = (LAS float*)(lds + L_HSUM);
    const int d = tid & 255, half = tid >> 8;
    float w[16];
#pragma unroll
    for (int r = 0; r < 16; ++r) w[r] = wg[r * 1024 + h * 256 + d];
    const float bias = bg[h * 256 + d];
    LDS_BAR();
    float gv[32]; float tot = 0.f;
#pragma unroll
    for (int jj = 0; jj < 32; ++jj) { const int j = 32 * half + jj; const float g = j < ntok ? gate_val(glrS + j * 16, w, bias) : 0.f; gv[jj] = g; tot += g; }
    hsum[half * 256 + d] = tot;
    LDS_BAR();
    float run = half ? hsum[d] : 0.f; const float btot = hsum[d] + hsum[256 + d];
    if (MODE == 0) { if (half == 0 && dec_out) dec_out[d] = __expf(btot); }
#pragma unroll
    for (int jb = 0; jb < 4; ++jb) {
        float pk[8];
#pragma unroll
        for (int u = 0; u < 8; ++u) {
            const int j = 32 * half + 8 * jb + u; run += gv[8 * jb + u];
            if (MODE == 0) pk[u] = bf2f(((const LAS bf16_t*)(lds + L_KRAW))[j * QK_P + d]) * __expf(btot - run);
            else {
                LAS bf16_t* qp = (LAS bf16_t*)(lds + L_QT) + j * QK_P + d; LAS bf16_t* kp = (LAS bf16_t*)(lds + L_KT) + j * QK_P + d;
                *qp = (bf16_t)f2bf(bf2f(*qp) * __expf(run)); *kp = (bf16_t)f2bf(bf2f(*kp) * __expf(-run));
            }
        }
        if (MODE == 0) { u32x4 o; o.x = pk2(pk[0], pk[1]); o.y = pk2(pk[2], pk[3]); o.z = pk2(pk[4], pk[5]); o.w = pk2(pk[6], pk[7]);
            *(LAS u32x4*)((LAS bf16_t*)(lds + L_KET) + d * KET_P + 32 * half + 8 * jb) = o; }
    }
}

__device__ __forceinline__ void gla_tile_a(LAS unsigned char* lds, int tid, int row0, int ntok, int h, const float* GLR, const float* wg, const float* bg,
                                           const bf16_t* Kb, const bf16_t* Vb, bf16_t* dsout, float* dec_out) {
    LDS_BAR();
    stage_glr(lds, tid, GLR, row0, ntok);
    stage_rows<32, QK_P>((LAS bf16_t*)(lds + L_KRAW), tid, Kb, 1024, row0, ntok, h * 256);
    stage_rows<64, VS_P>((LAS bf16_t*)(lds + L_VS), tid, Vb, 2048, row0, ntok, h * 512);
    gate_pass<0>(lds, tid, ntok, h, wg, bg, dec_out);
    LDS_BAR();
    const int lane = tid & 63, w = tid >> 6, li = lane & 15, g = lane >> 4;
    const LAS bf16_t* VS = (const LAS bf16_t*)(lds + L_VS); const LAS bf16_t* KET = (const LAS bf16_t*)(lds + L_KET);
#pragma unroll 1
    for (int eb = 0; eb < 4; ++eb) {
        const int e0 = 64 * w + 16 * eb;
        bf16x8 vy[2];
#pragma unroll
        for (int ks = 0; ks < 2; ++ks) { const LAS bf16_t* a = VS + (32 * ks + 8 * g + (li >> 2)) * VS_P + e0 + 4 * (li & 3); vy[ks] = cat8(vtr(a), vtr(a + 4 * VS_P)); }
#pragma unroll
        for (int sb = 0; sb < 4; ++sb) {
            f32x4 acc[4];
#pragma unroll
            for (int db = 0; db < 4; ++db) {
                const LAS bf16_t* kp = KET + (64 * sb + 16 * (li >> 2) + 4 * db + (li & 3)) * KET_P + 8 * g;
                const bf16x8 x0 = *(const LAS bf16x8*)kp, x1 = *(const LAS bf16x8*)(kp + 32);
                f32x4 a = (f32x4){0.f, 0.f, 0.f, 0.f};
                a = MFMA16(x0, vy[0], a); a = MFMA16(x1, vy[1], a); acc[db] = a;
            }
            bf16_t* op = dsout + (size_t)(e0 + li) * 256 + 64 * sb + 16 * g;
            *(u32x4*)op = (u32x4){pk2(acc[0][0], acc[0][1]), pk2(acc[0][2], acc[0][3]), pk2(acc[1][0], acc[1][1]), pk2(acc[1][2], acc[1][3])};
            *(u32x4*)(op + 8) = (u32x4){pk2(acc[2][0], acc[2][1]), pk2(acc[2][2], acc[2][3]), pk2(acc[3][0], acc[3][1]), pk2(acc[3][2], acc[3][3])};
        }
    }
}

__device__ __forceinline__ void gla_tile_c(LAS unsigned char* lds, int tid, int row0, int ntok, int h, const float* GLR, const float* wg, const float* bg,
                                           const bf16_t* Qb, const bf16_t* Kb, const bf16_t* Vb, const bf16_t* __restrict__ Sin, const float* __restrict__ onorm,
                                           const bf16_t* __restrict__ SG, bf16_t* OG) {
    const int lane = tid & 63, w = tid >> 6, li = lane & 15, g = lane >> 4;
    LDS_BAR();
    stage_glr(lds, tid, GLR, row0, ntok);
    stage_rows<32, QK_P>((LAS bf16_t*)(lds + L_QT), tid, Qb, 1024, row0, ntok, h * 256);
    stage_rows<32, QK_P>((LAS bf16_t*)(lds + L_KT), tid, Kb, 1024, row0, ntok, h * 256);
    stage_rows<64, VS_P>((LAS bf16_t*)(lds + L_VS), tid, Vb, 2048, row0, ntok, h * 512);
    const bf16_t* sp = Sin ? Sin + (size_t)(64 * w + 16 * (li >> 2) + (li & 3)) * 256 + 8 * g : nullptr;
    bf16x8 s0[8], s1[8];
    if (Sin) {
#pragma unroll
        for (int ks = 0; ks < 8; ++ks) s0[ks] = *(const bf16x8*)(sp + 32 * ks);
    }
    gate_pass<1>(lds, tid, ntok, h, wg, bg, nullptr);
    LDS_BAR();
    if (Sin) {
#pragma unroll
        for (int ks = 0; ks < 8; ++ks) s1[ks] = *(const bf16x8*)(sp + (size_t)4 * 256 + 32 * ks);
    }
    const LAS bf16_t* VS = (const LAS bf16_t*)(lds + L_VS); const LAS bf16_t* QT = (const LAS bf16_t*)(lds + L_QT); const LAS bf16_t* KT = (const LAS bf16_t*)(lds + L_KT);
    LAS bf16_t* ATT = (LAS bf16_t*)(lds + L_KT);
    const int ib0 = w >> 1;
    f32x4 at[2];
#pragma unroll
    for (int jj = 0; jj < 2; ++jj) {
        const int jb = 2 * (w & 1) + jj; f32x4 a = (f32x4){0.f, 0.f, 0.f, 0.f};
        if (jb <= ib0) {
#pragma unroll
            for (int ks = 0; ks < 8; ++ks) { const bf16x8 x = *(const LAS bf16x8*)(KT + (16 * jb + li) * QK_P + 32 * ks + 8 * g); const bf16x8 y = *(const LAS bf16x8*)(QT + (16 * ib0 + li) * QK_P + 32 * ks + 8 * g); a = MFMA16(x, y, a); }
        }
        const int i = 16 * ib0 + li;
#pragma unroll
        for (int r = 0; r < 4; ++r) { const int j = 16 * jb + 4 * g + r; if (j > i) a[r] = 0.f; }
        at[jj] = a;
    }
    LDS_BAR();
#pragma unroll
    for (int jj = 0; jj < 2; ++jj) { const int jb = 2 * (w & 1) + jj;
        *(LAS u32x2*)(ATT + (16 * ib0 + li) * ATT_P + 16 * jb + 4 * g) = (u32x2){pk2(at[jj][0], at[jj][1]), pk2(at[jj][2], at[jj][3])}; }
    LDS_BAR();
    f32x4 acc[4][4];
#pragma unroll
    for (int a = 0; a < 4; ++a)
#pragma unroll
        for (int b = 0; b < 4; ++b) acc[a][b] = (f32x4){0.f, 0.f, 0.f, 0.f};
#pragma unroll
    for (int eb = 0; eb < 4; ++eb) {
#pragma unroll
        for (int ks = 0; ks < 2; ++ks) {
            const LAS bf16_t* a = VS + (32 * ks + 8 * g + (li >> 2)) * VS_P + 64 * w + 16 * (li & 3) + 4 * eb; const bf16x8 x = cat8(vtr(a), vtr(a + 4 * VS_P));
#pragma unroll
            for (int ib = 0; ib < 4; ++ib) { const bf16x8 y = *(const LAS bf16x8*)(ATT + (16 * ib + li) * ATT_P + 32 * ks + 8 * g); acc[eb][ib] = MFMA16(x, y, acc[eb][ib]); }
        }
        if (Sin) {
#pragma unroll
            for (int ks = 0; ks < 8; ++ks) {
                const bf16x8 x = (eb & 1) ? s1[ks] : s0[ks];
#pragma unroll
                for (int ib = 0; ib < 4; ++ib) { const bf16x8 y = *(const LAS bf16x8*)(QT + (16 * ib + li) * QK_P + 32 * ks + 8 * g); acc[eb][ib] = MFMA16(x, y, acc[eb][ib]); }
            }
            if (eb < 2) {
#pragma unroll
                for (int ks = 0; ks < 8; ++ks) { const bf16x8 nv = *(const bf16x8*)(sp + (size_t)(4 * (eb + 2)) * 256 + 32 * ks); if (eb & 1) s1[ks] = nv; else s0[ks] = nv; }
            }
        }
    }
    LAS float* rowsq = (LAS float*)(lds + L_ROWSQ);
#pragma unroll
    for (int ib = 0; ib < 4; ++ib) { float ss = 0.f;
#pragma unroll
        for (int eb = 0; eb < 4; ++eb) { const f32x4 v = acc[eb][ib]; ss += (v[0] * v[0] + v[1] * v[1]) + (v[2] * v[2] + v[3] * v[3]); }
        ss += __shfl_xor(ss, 16); ss += __shfl_xor(ss, 32);
        if (g == 0) rowsq[(16 * ib + li) * 8 + w] = ss; }
    LDS_BAR();
    const int e = 64 * w + 16 * g;
    f32x4 on[4];
#pragma unroll
    for (int q = 0; q < 4; ++q) on[q] = *(const f32x4*)(onorm + e + 4 * q);
#pragma unroll
    for (int ib = 0; ib < 4; ++ib) { const int i = 16 * ib + li;
        const f32x4 q0 = *(const LAS f32x4*)(rowsq + i * 8), q1 = *(const LAS f32x4*)(rowsq + i * 8 + 4);
        const float rinv = rsqrtf(((q0[0] + q0[1]) + (q0[2] + q0[3]) + (q1[0] + q1[1]) + (q1[2] + q1[3])) * (1.0f / 512.0f) + EPS);
        if (i < ntok) {
            const size_t off = (size_t)(row0 + i) * 2048 + h * 512 + e;
            const u32x4 g0 = *(const u32x4*)(SG + off), g1 = *(const u32x4*)(SG + off + 8);
            const f32x4 v0 = acc[0][ib] * on[0] * rinv, v1 = acc[1][ib] * on[1] * rinv, v2 = acc[2][ib] * on[2] * rinv, v3 = acc[3][ib] * on[3] * rinv;
            *(u32x4*)(OG + off) = (u32x4){pk2(v0[0] * bflo(g0.x), v0[1] * bfhi(g0.x)), pk2(v0[2] * bflo(g0.y), v0[3] * bfhi(g0.y)), pk2(v1[0] * bflo(g0.z), v1[1] * bfhi(g0.z)), pk2(v1[2] * bflo(g0.w), v1[3] * bfhi(g0.w))};
            *(u32x4*)(OG + off + 8) = (u32x4){pk2(v2[0] * bflo(g1.x), v2[1] * bfhi(g1.x)), pk2(v2[2] * bflo(g1.y), v2[3] * bfhi(g1.y)), pk2(v3[0] * bflo(g1.z), v3[1] * bfhi(g1.z)), pk2(v3[2] * bflo(g1.w), v3[3] * bfhi(g1.w))};
        }
    }
}

__device__ __forceinline__ void gla_tile_sample(LAS unsigned char* lds, int tid, int bs, int h, int eh, const float* GLR, const float* wg, const float* bg,
                                                const bf16_t* Qb, const bf16_t* Kb, const bf16_t* Vb, const float* __restrict__ S0, float* __restrict__ Sout, float* ORAW) {
    __syncthreads();
    LAS float* coef = (LAS float*)lds;
    LAS float* glrS = (LAS float*)(lds + 16384);
    LAS float* red = (LAS float*)(lds + 16640);
    LAS float* attS = (LAS float*)(lds + 16896);
    LAS float* ored = (LAS float*)(lds + 20480);
    const int row0 = ROW_SAMP + 4 * bs, lane = tid & 63, wv = tid >> 6;
    if (tid < 64) glrS[tid] = GLR[(size_t)row0 * 16 + tid];
    __syncthreads();
    if (tid < 256) {
        const int d = tid; float w[16];
#pragma unroll
        for (int r = 0; r < 16; ++r) w[r] = wg[r * 1024 + h * 256 + d];
        const float bias = bg[h * 256 + d];
        float b[4], run = 0.f;
#pragma unroll
        for (int t = 0; t < 4; ++t) { run += gate_val(glrS + t * 16, w, bias); b[t] = run; }
        float qd[4], kd[4];
#pragma unroll
        for (int t = 0; t < 4; ++t) { const float q = bf2f(Qb[(size_t)(row0 + t) * 1024 + h * 256 + d]), k = bf2f(Kb[(size_t)(row0 + t) * 1024 + h * 256 + d]);
            qd[t] = q * __expf(b[t]); kd[t] = k * __expf(-b[t]); coef[d * 12 + t] = qd[t]; coef[d * 12 + 4 + t] = k * __expf(run - b[t]); }
        coef[d * 12 + 8] = __expf(run);
#pragma unroll
        for (int t = 0; t < 4; ++t)
#pragma unroll
            for (int j = 0; j <= t; ++j) { const float s = wave_sum(qd[t] * kd[j]); if (lane == 0) red[wv * 10 + t * (t + 1) / 2 + j] = s; }
    }
    __syncthreads();
    if (tid < 10) attS[tid] = (red[tid] + red[10 + tid]) + (red[20 + tid] + red[30 + tid]);
    const int e4 = tid & 63, e = eh * 256 + 4 * e4;
    f32x4 v[4];
#pragma unroll
    for (int j = 0; j < 4; ++j) { const u32x2 raw = *(const u32x2*)(Vb + (size_t)(row0 + j) * 2048 + h * 512 + e); v[j] = (f32x4){bflo(raw.x), bfhi(raw.x), bflo(raw.y), bfhi(raw.y)}; }
    f32x4 o[4];
#pragma unroll
    for (int t = 0; t < 4; ++t) o[t] = (f32x4){0.f, 0.f, 0.f, 0.f};
    f32x4 sbuf[16];
#pragma unroll
    for (int it = 0; it < 16; ++it) sbuf[it] = __builtin_nontemporal_load((const f32x4*)(S0 + (size_t)(wv + 8 * it) * 512 + e));
#pragma unroll
    for (int it = 0; it < 32; ++it) {
        const int d = wv + 8 * it;
        const f32x4 s = sbuf[it & 15];
        if (it + 16 < 32) sbuf[it & 15] = __builtin_nontemporal_load((const f32x4*)(S0 + (size_t)(wv + 8 * (it + 16)) * 512 + e));
        const f32x4 c0 = *(const LAS f32x4*)(coef + d * 12), c1 = *(const LAS f32x4*)(coef + d * 12 + 4); const float dc = coef[d * 12 + 8];
#pragma unroll
        for (int t = 0; t < 4; ++t) o[t] += s * c0[t];
        f32x4 sn = s * dc;
#pragma unroll
        for (int j = 0; j < 4; ++j) sn += v[j] * c1[j];
        __builtin_nontemporal_store(sn, (f32x4*)(Sout + (size_t)d * 512 + e));
    }
#pragma unroll
    for (int t = 0; t < 4; ++t) *(LAS f32x4*)(ored + (wv * 4 + t) * 256 + 4 * e4) = o[t];
    __syncthreads();
    if (tid < 256) {
        float vv[4];
#pragma unroll
        for (int j = 0; j < 4; ++j) vv[j] = bf2f(Vb[(size_t)(row0 + j) * 2048 + h * 512 + eh * 256 + tid]);
#pragma unroll
        for (int t = 0; t < 4; ++t) { float s = 0.f;
#pragma unroll
            for (int q = 0; q < 8; ++q) s += ored[(q * 4 + t) * 256 + tid];
#pragma unroll
            for (int j = 0; j <= t; ++j) s += attS[t * (t + 1) / 2 + j] * vv[j];
            ORAW[((size_t)(bs * 4 + h) * 4 + t) * 512 + eh * 256 + tid] = s; }
    }
}

__device__ __forceinline__ void gla_tile_sample_full(LAS unsigned char* lds, int tid, int bs, int h, const float* GLR, const float* wg, const float* bg,
                                                     const bf16_t* Qb, const bf16_t* Kb, const bf16_t* Vb, const float* __restrict__ S0, float* __restrict__ Sout,
                                                     const float* __restrict__ onorm, const bf16_t* __restrict__ SG, bf16_t* OG) {
    LDS_BAR();
    LAS float* coef = (LAS float*)lds;
    LAS float* glrS = (LAS float*)(lds + 16384);
    LAS float* red = (LAS float*)(lds + 16640);
    LAS float* attS = (LAS float*)(lds + 16896);
    LAS float* ored = (LAS float*)(lds + 20480);
    LAS float* ssqS = (LAS float*)(lds + 20480 + 32768);
    const int row0 = ROW_SAMP + 4 * bs, lane = tid & 63, wv = tid >> 6;
    if (tid < 64) glrS[tid] = GLR[(size_t)row0 * 16 + tid];
    LDS_BAR();
    if (tid < 256) {
        const int d = tid; float w[16];
#pragma unroll
        for (int r = 0; r < 16; ++r) w[r] = wg[r * 1024 + h * 256 + d];
        const float bias = bg[h * 256 + d];
        float b[4], run = 0.f;
#pragma unroll
        for (int t = 0; t < 4; ++t) { run += gate_val(glrS + t * 16, w, bias); b[t] = run; }
        float qd[4], kd[4];
#pragma unroll
        for (int t = 0; t < 4; ++t) { const float q = bf2f(Qb[(size_t)(row0 + t) * 1024 + h * 256 + d]), k = bf2f(Kb[(size_t)(row0 + t) * 1024 + h * 256 + d]);
            qd[t] = q * __expf(b[t]); kd[t] = k * __expf(-b[t]); coef[d * 12 + t] = qd[t]; coef[d * 12 + 4 + t] = k * __expf(run - b[t]); }
        coef[d * 12 + 8] = __expf(run);
#pragma unroll
        for (int t = 0; t < 4; ++t)
#pragma unroll
            for (int j = 0; j <= t; ++j) { const float s = wave_sum(qd[t] * kd[j]); if (lane == 0) red[wv * 10 + t * (t + 1) / 2 + j] = s; }
    }
    LDS_BAR();
    if (tid < 10) attS[tid] = (red[tid] + red[10 + tid]) + (red[20 + tid] + red[30 + tid]);
    const int e4 = tid & 127, e = 4 * e4, dsub = tid >> 7;
    f32x4 v[4];
#pragma unroll
    for (int j = 0; j < 4; ++j) { const u32x2 raw = *(const u32x2*)(Vb + (size_t)(row0 + j) * 2048 + h * 512 + e); v[j] = (f32x4){bflo(raw.x), bfhi(raw.x), bflo(raw.y), bfhi(raw.y)}; }
    f32x4 o[4];
#pragma unroll
    for (int t = 0; t < 4; ++t) o[t] = (f32x4){0.f, 0.f, 0.f, 0.f};
    f32x4 sbuf[16];
#pragma unroll
    for (int it = 0; it < 16; ++it) sbuf[it] = __builtin_nontemporal_load((const f32x4*)(S0 + (size_t)(dsub + 4 * it) * 512 + e));
#pragma unroll
    for (int it = 0; it < 64; ++it) {
        const int d = dsub + 4 * it;
        const f32x4 s = sbuf[it & 15];
        if (it + 16 < 64) sbuf[it & 15] = __builtin_nontemporal_load((const f32x4*)(S0 + (size_t)(dsub + 4 * (it + 16)) * 512 + e));
        const f32x4 c0 = *(const LAS f32x4*)(coef + d * 12), c1 = *(const LAS f32x4*)(coef + d * 12 + 4); const float dc = coef[d * 12 + 8];
#pragma unroll
        for (int t = 0; t < 4; ++t) o[t] += s * c0[t];
        f32x4 sn = s * dc;
#pragma unroll
        for (int j = 0; j < 4; ++j) sn += v[j] * c1[j];
        __builtin_nontemporal_store(sn, (f32x4*)(Sout + (size_t)d * 512 + e));
    }
#pragma unroll
    for (int t = 0; t < 4; ++t) *(LAS f32x4*)(ored + (dsub * 4 + t) * 512 + 4 * e4) = o[t];
    LDS_BAR();
    float of[4], vv[4];
#pragma unroll
    for (int j = 0; j < 4; ++j) vv[j] = bf2f(Vb[(size_t)(row0 + j) * 2048 + h * 512 + tid]);
#pragma unroll
    for (int t = 0; t < 4; ++t) { float s = (ored[(0 * 4 + t) * 512 + tid] + ored[(1 * 4 + t) * 512 + tid]) + (ored[(2 * 4 + t) * 512 + tid] + ored[(3 * 4 + t) * 512 + tid]);
#pragma unroll
        for (int j = 0; j <= t; ++j) s += attS[t * (t + 1) / 2 + j] * vv[j];
        of[t] = s; const float q = wave_sum(s * s); if (lane == 0) ssqS[wv * 4 + t] = q; }
    LDS_BAR();
    const float on = onorm[tid];
#pragma unroll
    for (int t = 0; t < 4; ++t) { float tot = 0.f;
#pragma unroll
        for (int q = 0; q < 8; ++q) tot += ssqS[q * 4 + t];
        const float rinv = rsqrtf(tot * (1.0f / 512.0f) + EPS);
        const size_t off = (size_t)(row0 + t) * 2048 + h * 512 + tid;
        OG[off] = (bf16_t)pk2(of[t] * rinv * on * bf2f(SG[off]), 0.f); }
}

__device__ __forceinline__ void gla_tile_sample_fin(int tid, int bs, const float* __restrict__ ORAW, const float* __restrict__ onorm, const bf16_t* __restrict__ SG, bf16_t* OG) {
    const int lane = tid & 63, wv = tid >> 6;
#pragma unroll
    for (int rr = 0; rr < 2; ++rr) { const int rowid = 2 * wv + rr, h = rowid >> 2, t = rowid & 3; const int row = ROW_SAMP + 4 * bs + t;
        const float* op = ORAW + ((size_t)(bs * 4 + h) * 4 + t) * 512 + 8 * lane;
        const f32x4 a = *(const f32x4*)op, b = *(const f32x4*)(op + 4);
        float ss = (a[0] * a[0] + a[1] * a[1]) + (a[2] * a[2] + a[3] * a[3]) + (b[0] * b[0] + b[1] * b[1]) + (b[2] * b[2] + b[3] * b[3]);
        ss = wave_sum(ss); const float rinv = rsqrtf(ss * (1.0f / 512.0f) + EPS);
        const size_t off = (size_t)row * 2048 + h * 512 + 8 * lane; const u32x4 sg = *(const u32x4*)(SG + off);
        const f32x4 n0 = *(const f32x4*)(onorm + 8 * lane), n1 = *(const f32x4*)(onorm + 8 * lane + 4);
        u32x4 o; o.x = pk2(a[0] * rinv * n0[0] * bflo(sg.x), a[1] * rinv * n0[1] * bfhi(sg.x)); o.y = pk2(a[2] * rinv * n0[2] * bflo(sg.y), a[3] * rinv * n0[3] * bfhi(sg.y));
        o.z = pk2(b[0] * rinv * n1[0] * bflo(sg.z), b[1] * rinv * n1[1] * bfhi(sg.z)); o.w = pk2(b[2] * rinv * n1[2] * bflo(sg.w), b[3] * rinv * n1[3] * bfhi(sg.w));
        *(u32x4*)(OG + off) = o; }
}

__device__ __forceinline__ void gla_scan(LAS unsigned char* lds, int tid, int bid, int G, bf16_t* DS, const bf16_t* __restrict__ DSM, const float* __restrict__ DEC, float* __restrict__ sp_out) {
    LAS float* decS = (LAS float*)lds;
    LAS float* stT = (LAS float*)(lds + 65536);
#pragma unroll 1
    for (int blk = bid; blk < 256; blk += G) {
        const int bh = blk >> 5, b = bh >> 2, h = bh & 3, e0 = (blk & 31) * 16, el = tid >> 5, e = e0 + el, d8 = tid & 31;
        LDS_BAR();
#pragma unroll
        for (int i = 0; i < 8; ++i) { const int idx = tid + NTHR * i, c = idx >> 6, q = idx & 63;
            *(LAS f32x4*)(decS + c * 256 + q * 4) = *(const f32x4*)(DEC + ((size_t)(b * 64 + c) * 4 + h) * 256 + q * 4); }
        float S[8];
        { const u32x4 m = *(const u32x4*)(DSM + ((size_t)h * 512 + e) * 256 + d8 * 8);
          S[0] = bflo(m.x); S[1] = bfhi(m.x); S[2] = bflo(m.y); S[3] = bfhi(m.y); S[4] = bflo(m.z); S[5] = bfhi(m.z); S[6] = bflo(m.w); S[7] = bfhi(m.w); }
        bf16_t* dsp = DS + (((size_t)(b * 64) * 4 + h) * 512 + e) * 256 + d8 * 8;
        constexpr size_t CS = (size_t)4 * 512 * 256;
        u32x4 buf[16];
#pragma unroll
        for (int u = 0; u < 16; ++u) buf[u] = *(const u32x4*)(dsp + u * CS);
        LDS_BAR();
#pragma unroll
        for (int c = 0; c < 64; ++c) { const u32x4 dv = buf[c & 15];
            if (c + 16 < 64) buf[c & 15] = *(const u32x4*)(dsp + (size_t)(c + 16) * CS);
            const f32x4 d0 = *(const LAS f32x4*)(decS + c * 256 + d8 * 8), d1 = *(const LAS f32x4*)(decS + c * 256 + d8 * 8 + 4);
            u32x4 o; o.x = pk2(S[0], S[1]); o.y = pk2(S[2], S[3]); o.z = pk2(S[4], S[5]); o.w = pk2(S[6], S[7]);
            *(u32x4*)(dsp + c * CS) = o;
            S[0] = S[0] * d0[0] + bflo(dv.x); S[1] = S[1] * d0[1] + bfhi(dv.x); S[2] = S[2] * d0[2] + bflo(dv.y); S[3] = S[3] * d0[3] + bfhi(dv.y);
            S[4] = S[4] * d1[0] + bflo(dv.z); S[5] = S[5] * d1[1] + bfhi(dv.z); S[6] = S[6] * d1[2] + bflo(dv.w); S[7] = S[7] * d1[3] + bfhi(dv.w); }
#pragma unroll
        for (int u = 0; u < 8; ++u) stT[(d8 * 8 + u) * 17 + el] = S[u];
        LDS_BAR();
#pragma unroll
        for (int i = 0; i < 8; ++i) { const int idx = tid + NTHR * i, d = idx >> 4, q = idx & 15;
            sp_out[((size_t)bh * 256 + d) * 512 + e0 + q] = stT[d * 17 + q]; }
    }
}

template <class Epi>
__device__ __forceinline__ void tail_gemm_unit(LAS unsigned char* lds, int tid, const bf16_t* __restrict__ A, const bf16_t* __restrict__ Bt, int n0, int rh, const Epi& E) {
    const int lane = tid & 63, w = tid >> 6, li = lane & 15, g = lane >> 4;
    const bf16_t* ap = A + (size_t)(ROW_META + 80 * rh + li) * DM + 256 * w + 8 * g;
    const bf16_t* bp = Bt + (size_t)(n0 + 16 * (li >> 2) + (li & 3)) * DM + 256 * w + 8 * g;
    f32x4 acc[5][4];
#pragma unroll
    for (int a = 0; a < 5; ++a)
#pragma unroll
        for (int b = 0; b < 4; ++b) acc[a][b] = (f32x4){0.f, 0.f, 0.f, 0.f};
    bf16x8 fa[3][5], fb[3][4];
#define TG_LOAD(st, ks) do { _Pragma("unroll") for (int q_ = 0; q_ < 5; ++q_) fa[st][q_] = *(const bf16x8*)(ap + (size_t)(16 * q_) * DM + 32 * (ks)); \
                             _Pragma("unroll") for (int q_ = 0; q_ < 4; ++q_) fb[st][q_] = *(const bf16x8*)(bp + (size_t)(4 * q_) * DM + 32 * (ks)); } while (0)
    TG_LOAD(0, 0); TG_LOAD(1, 1); TG_LOAD(2, 2);
#pragma unroll
    for (int ks = 0; ks < 8; ++ks) {
#pragma unroll
        for (int rb = 0; rb < 5; ++rb)
#pragma unroll
            for (int cb = 0; cb < 4; ++cb) acc[rb][cb] = MFMA16(fb[ks % 3][cb], fa[ks % 3][rb], acc[rb][cb]);
        if (ks + 3 < 8) TG_LOAD(ks % 3, ks + 3);
    }
#undef TG_LOAD
    LAS f32x4* red = (LAS f32x4*)lds;
    LDS_BAR();
    if (w >= 4) {
#pragma unroll
        for (int rb = 0; rb < 5; ++rb)
#pragma unroll
            for (int cb = 0; cb < 4; ++cb) red[((w - 4) * 20 + rb * 4 + cb) * 64 + lane] = acc[rb][cb];
    }
    LDS_BAR();
    if (w < 4) {
#pragma unroll
        for (int rb = 0; rb < 5; ++rb)
#pragma unroll
            for (int cb = 0; cb < 4; ++cb) acc[rb][cb] += red[(w * 20 + rb * 4 + cb) * 64 + lane];
    }
    LDS_BAR();
    if (w < 4) {
#pragma unroll
        for (int rb = 0; rb < 5; ++rb)
#pragma unroll
            for (int cb = 0; cb < 4; ++cb) red[(w * 20 + rb * 4 + cb) * 64 + lane] = acc[rb][cb];
    }
    LDS_BAR();
    if (w < 5 && rh * 5 + w < 9) {
        f32x4 v[4];
#pragma unroll
        for (int cb = 0; cb < 4; ++cb) v[cb] = (red[(0 * 20 + w * 4 + cb) * 64 + lane] + red[(1 * 20 + w * 4 + cb) * 64 + lane]) + (red[(2 * 20 + w * 4 + cb) * 64 + lane] + red[(3 * 20 + w * 4 + cb) * 64 + lane]);
        E.tail16(ROW_META + 80 * rh + 16 * w + li, n0 + 16 * g, v[0], v[1], v[2], v[3]);
    }
}

__device__ __forceinline__ void glr_unit(LAS unsigned char* lds, int tid, const bf16_t* __restrict__ A, const bf16_t* __restrict__ Bt, int unit, const float* __restrict__ ssq, float* GLR) {
    const int lane = tid & 63, w = tid >> 6, li = lane & 15, g = lane >> 4;
    const bf16_t* ap = A + (size_t)(32 * unit + li) * DM + 256 * w + 8 * g;
    const bf16_t* bp = Bt + (size_t)(6144 + li) * DM + 256 * w + 8 * g;
    bf16x8 fa[8][2], fb[8];
#pragma unroll
    for (int ks = 0; ks < 8; ++ks) { fa[ks][0] = *(const bf16x8*)(ap + 32 * ks); fa[ks][1] = *(const bf16x8*)(ap + (size_t)16 * DM + 32 * ks); fb[ks] = *(const bf16x8*)(bp + 32 * ks); }
    f32x4 acc[2] = {(f32x4){0.f, 0.f, 0.f, 0.f}, (f32x4){0.f, 0.f, 0.f, 0.f}};
#pragma unroll
    for (int ks = 0; ks < 8; ++ks) { acc[0] = MFMA16(fb[ks], fa[ks][0], acc[0]); acc[1] = MFMA16(fb[ks], fa[ks][1], acc[1]); }
    LAS f32x4* red = (LAS f32x4*)lds;
    LDS_BAR();
    red[(w * 2 + 0) * 64 + lane] = acc[0]; red[(w * 2 + 1) * 64 + lane] = acc[1];
    LDS_BAR();
    if (w < 2) {
        f32x4 s = (f32x4){0.f, 0.f, 0.f, 0.f};
#pragma unroll
        for (int q = 0; q < 8; ++q) s += red[(q * 2 + w) * 64 + lane];
        const int row = 32 * unit + 16 * w + li; const float rs = pg8::row_rinv(ssq, row);
        *(f32x4*)(GLR + (size_t)row * 16 + 4 * g) = s * rs;
    }
    LDS_BAR();
}
constexpr int KS_P = 72;
constexpr int L_KS = 0, L_VS2 = 192 * KS_P * 2;
__device__ __forceinline__ int seq_row(int t, int b) { return t >= 0 ? b * 4096 + t : ROW_META + 16 + t; }

constexpr int L_VS2B = 256 * KS_P * 2;
__device__ __forceinline__ void swa_tile(LAS unsigned char* lds, int tid, int b, int tq0, int kvh, int nq, const bf16_t* __restrict__ KV, const bf16_t* __restrict__ QS,
                                         const bf16_t* __restrict__ SG, const float* __restrict__ sinks, bf16_t* OG) {
    const int lane = tid & 63, w = tid >> 6, li = lane & 15, g = lane >> 4, hg = w >> 1, qh = w & 1, head = kvh * 4 + hg;
    LAS bf16_t* KS = (LAS bf16_t*)(lds + L_KS); LAS bf16_t* VS = (LAS bf16_t*)(lds + L_VS2B);
    bf16x8 qa[2][2], qn[2][2];
#pragma unroll
    for (int qb = 0; qb < 2; ++qb) { const int i = 32 * qh + 16 * qb + li; const size_t rq = (size_t)seq_row(tq0 + i, b) * 2048 + head * 64;
        qa[qb][0] = *(const bf16x8*)(QS + rq + 8 * g); qa[qb][1] = *(const bf16x8*)(QS + rq + 8 * g + 32); }
    const float sink = sinks[head];
    LDS_BAR();
#pragma unroll
    for (int i = 0; i < 8; ++i) { const int chunk = tid + NTHR * i, kk = chunk >> 4, c = chunk & 15, isv = c >> 3, c8 = c & 7; const int t = tq0 - 128 + kk;
        u32x4 v = (u32x4){0u, 0u, 0u, 0u}; if (t >= -16 && t < 4096) v = *(const u32x4*)(KV + (size_t)seq_row(t, b) * 1024 + isv * 512 + kvh * 64 + c8 * 8);
        *(LAS u32x4*)((isv ? VS : KS) + kk * KS_P + c8 * 8) = v; }
    LDS_BAR();
#pragma unroll
    for (int h2 = 0; h2 < 2; ++h2) {
        const int kb0 = 4 * h2 + 2 * qh;
        if (h2 == 0) {
#pragma unroll
            for (int qb = 0; qb < 2; ++qb) { const int i = 64 + 32 * qh + 16 * qb + li; const size_t rq = (size_t)seq_row(tq0 + i, b) * 2048 + head * 64; qn[qb][0] = *(const bf16x8*)(QS + rq + 8 * g); qn[qb][1] = *(const bf16x8*)(QS + rq + 8 * g + 32); }
        }
#pragma unroll
        for (int qb = 0; qb < 2; ++qb) {
            if (64 * h2 + 32 * qh + 16 * qb >= nq) continue;
            const int i = 64 * h2 + 32 * qh + 16 * qb + li; const size_t ro = (size_t)seq_row(tq0 + i, b) * 2048 + head * 64 + 16 * g;
            const u32x4 g0 = *(const u32x4*)(SG + ro), g1 = *(const u32x4*)(SG + ro + 8);
            f32x4 s[10];
#pragma unroll
            for (int kb = 0; kb < 10; ++kb) { const LAS bf16_t* kp = KS + (16 * (kb0 + kb) + li) * KS_P + 8 * g;
                const bf16x8 x0 = *(const LAS bf16x8*)kp, x1 = *(const LAS bf16x8*)(kp + 32);
                f32x4 a = (f32x4){0.f, 0.f, 0.f, 0.f}; a = MFMA16(x0, qa[qb][0], a); a = MFMA16(x1, qa[qb][1], a); s[kb] = a;
                if (kb == 3 || kb == 6) asm volatile("" ::: "memory"); }
            float m = -1e30f;
#pragma unroll
            for (int kb = 0; kb < 10; ++kb)
#pragma unroll
                for (int r = 0; r < 4; ++r) { const int kk = 16 * (kb0 + kb) + 4 * g + r; const bool ok = (kk > i) && (kk <= i + 128) && (tq0 - 128 + kk >= -16);
                    if (!ok) s[kb][r] = -1e30f; m = fmaxf(m, s[kb][r]); }
            m = fmaxf(m, __shfl_xor(m, 16)); m = fmaxf(m, __shfl_xor(m, 32)); m = fmaxf(m, sink);
            float sum = 0.f;
#pragma unroll
            for (int kb = 0; kb < 10; ++kb)
#pragma unroll
                for (int r = 0; r < 4; ++r) { const float pv = s[kb][r] > -1e29f ? __expf(s[kb][r] - m) : 0.f; s[kb][r] = pv; sum += pv; }
            sum += __shfl_xor(sum, 16); sum += __shfl_xor(sum, 32);
            const float inv = 1.0f / (sum + __expf(sink - m));
            f32x4 o[4];
#pragma unroll
            for (int c4 = 0; c4 < 4; ++c4) o[c4] = (f32x4){0.f, 0.f, 0.f, 0.f};
#pragma unroll
            for (int k2 = 0; k2 < 5; ++k2) {
                const int kbase = 16 * kb0 + 32 * k2;
                const f32x4 a = s[2 * k2], cc = s[2 * k2 + 1]; u32x4 pw; pw.x = pk2(a[0], a[1]); pw.y = pk2(a[2], a[3]); pw.z = pk2(cc[0], cc[1]); pw.w = pk2(cc[2], cc[3]);
                const bf16x8 y = __builtin_bit_cast(bf16x8, pw);
#pragma unroll
                for (int db = 0; db < 4; ++db) { const LAS bf16_t* ap = VS + (kbase + 4 * g + (li >> 2)) * KS_P + 16 * (li & 3) + 4 * db; const bf16x8 x = cat8(vtr(ap), vtr(ap + 16 * KS_P));
                    o[db] = MFMA16(x, y, o[db]); }
            }
            if (i < nq) { const f32x4 v0 = o[0] * inv, v1 = o[1] * inv, v2 = o[2] * inv, v3 = o[3] * inv;
                *(u32x4*)(OG + ro) = (u32x4){pk2(v0[0] * bflo(g0.x), v0[1] * bfhi(g0.x)), pk2(v0[2] * bflo(g0.y), v0[3] * bfhi(g0.y)), pk2(v1[0] * bflo(g0.z), v1[1] * bfhi(g0.z)), pk2(v1[2] * bflo(g0.w), v1[3] * bfhi(g0.w))};
                *(u32x4*)(OG + ro + 8) = (u32x4){pk2(v2[0] * bflo(g1.x), v2[1] * bfhi(g1.x)), pk2(v2[2] * bflo(g1.y), v2[3] * bfhi(g1.y)), pk2(v3[0] * bflo(g1.z), v3[1] * bfhi(g1.z)), pk2(v3[2] * bflo(g1.w), v3[3] * bfhi(g1.w))}; }
        }
        if (h2 == 0) {
#pragma unroll
            for (int qb = 0; qb < 2; ++qb) { qa[qb][0] = qn[qb][0]; qa[qb][1] = qn[qb][1]; } }
    }
}

__device__ __forceinline__ void swa_decode_tile(LAS unsigned char* lds, int tid, int bs, int kvh, const float* __restrict__ ck, const float* __restrict__ cv, const bf16_t* __restrict__ KV,
                                                const bf16_t* __restrict__ QS, const bf16_t* __restrict__ SG, const float* __restrict__ sinks, bf16_t* OG) {
    LAS bf16_t* KS = (LAS bf16_t*)lds;
    LAS bf16_t* VS = (LAS bf16_t*)(lds + 144 * KS_P * 2);
    const int row0 = ROW_SAMP + 4 * bs, lane = tid & 63, w = tid >> 6, li = lane & 15, g = lane >> 4;
    f32x4 kl[4], vl[4];
#pragma unroll
    for (int i = 0; i < 4; ++i) { const int idx = tid + NTHR * i, key = idx >> 4, c4 = idx & 15; const size_t o = ((size_t)(bs * 128 + key) * 8 + kvh) * 64 + 4 * c4;
        kl[i] = __builtin_nontemporal_load((const f32x4*)(ck + o)); vl[i] = __builtin_nontemporal_load((const f32x4*)(cv + o)); }
    u32x2 kn = (u32x2){0u, 0u}, vn = (u32x2){0u, 0u};
    if (tid < 64) { const size_t o = (size_t)(row0 + (tid >> 4)) * 1024 + kvh * 64 + 4 * (tid & 15); kn = *(const u32x2*)(KV + o); vn = *(const u32x2*)(KV + o + 512); }
    const int tq = li >> 2, head = kvh * 4 + (li & 3);
    const size_t rq = (size_t)(row0 + tq) * 2048 + head * 64;
    bf16x8 qf0, qf1; u32x4 g0, g1; float sink = 0.f;
    if (w == 0) { qf0 = *(const bf16x8*)(QS + rq + 8 * g); qf1 = *(const bf16x8*)(QS + rq + 8 * g + 32); g0 = *(const u32x4*)(SG + rq + 16 * g); g1 = *(const u32x4*)(SG + rq + 16 * g + 8); sink = sinks[head]; }
    LDS_BAR();
#pragma unroll
    for (int i = 0; i < 4; ++i) { const int idx = tid + NTHR * i, key = idx >> 4, c4 = idx & 15;
        *(LAS u32x2*)(KS + key * KS_P + 4 * c4) = (u32x2){pk2(kl[i][0], kl[i][1]), pk2(kl[i][2], kl[i][3])};
        *(LAS u32x2*)(VS + key * KS_P + 4 * c4) = (u32x2){pk2(vl[i][0], vl[i][1]), pk2(vl[i][2], vl[i][3])}; }
    if (tid < 64) { *(LAS u32x2*)(KS + (128 + (tid >> 4)) * KS_P + 4 * (tid & 15)) = kn; *(LAS u32x2*)(VS + (128 + (tid >> 4)) * KS_P + 4 * (tid & 15)) = vn; }
    else { const int idx = tid - 64; if (idx < 12 * 16) *(LAS u32x2*)(KS + (132 + (idx >> 4)) * KS_P + 4 * (idx & 15)) = (u32x2){0u, 0u};
           if (idx < 28 * 16) *(LAS u32x2*)(VS + (132 + (idx >> 4)) * KS_P + 4 * (idx & 15)) = (u32x2){0u, 0u}; }
    LDS_BAR();
    if (w == 0) {
        f32x4 s[10];
#pragma unroll
        for (int kb = 0; kb < 9; ++kb) { const LAS bf16_t* kp = KS + (16 * kb + li) * KS_P + 8 * g;
            const bf16x8 x0 = *(const LAS bf16x8*)kp, x1 = *(const LAS bf16x8*)(kp + 32);
            f32x4 a = (f32x4){0.f, 0.f, 0.f, 0.f}; a = MFMA16(x0, qf0, a); a = MFMA16(x1, qf1, a); s[kb] = a; }
        s[9] = (f32x4){-1e30f, -1e30f, -1e30f, -1e30f};
        float m = -1e30f;
#pragma unroll
        for (int kb = 0; kb < 9; ++kb)
#pragma unroll
            for (int r = 0; r < 4; ++r) { const int kk = 16 * kb + 4 * g + r; const bool ok = kk < 128 ? (kk >= tq + 1) : (kk < 132 && kk - 128 <= tq);
                if (!ok) s[kb][r] = -1e30f; m = fmaxf(m, s[kb][r]); }
        m = fmaxf(m, __shfl_xor(m, 16)); m = fmaxf(m, __shfl_xor(m, 32)); m = fmaxf(m, sink);
        float sum = 0.f;
#pragma unroll
        for (int kb = 0; kb < 10; ++kb)
#pragma unroll
            for (int r = 0; r < 4; ++r) { const float pv = s[kb][r] > -1e29f ? __expf(s[kb][r] - m) : 0.f; s[kb][r] = pv; sum += pv; }
        sum += __shfl_xor(sum, 16); sum += __shfl_xor(sum, 32);
        const float inv = 1.0f / (sum + __expf(sink - m));
        f32x4 o[4];
#pragma unroll
        for (int c4 = 0; c4 < 4; ++c4) o[c4] = (f32x4){0.f, 0.f, 0.f, 0.f};
#pragma unroll
        for (int k2 = 0; k2 < 5; ++k2) {
            const int kbase = 32 * k2;
            const f32x4 a = s[2 * k2], cc = s[2 * k2 + 1]; u32x4 pw; pw.x = pk2(a[0], a[1]); pw.y = pk2(a[2], a[3]); pw.z = pk2(cc[0], cc[1]); pw.w = pk2(cc[2], cc[3]);
            const bf16x8 y = __builtin_bit_cast(bf16x8, pw);
#pragma unroll
            for (int db = 0; db < 4; ++db) { const LAS bf16_t* ap = VS + (kbase + 4 * g + (li >> 2)) * KS_P + 16 * (li & 3) + 4 * db; const bf16x8 x = cat8(vtr(ap), vtr(ap + 16 * KS_P));
                o[db] = MFMA16(x, y, o[db]); }
        }
        const f32x4 v0 = o[0] * inv, v1 = o[1] * inv, v2 = o[2] * inv, v3 = o[3] * inv; const size_t ro = rq + 16 * g;
        *(u32x4*)(OG + ro) = (u32x4){pk2(v0[0] * bflo(g0.x), v0[1] * bfhi(g0.x)), pk2(v0[2] * bflo(g0.y), v0[3] * bfhi(g0.y)), pk2(v1[0] * bflo(g0.z), v1[1] * bfhi(g0.z)), pk2(v1[2] * bflo(g0.w), v1[3] * bfhi(g0.w))};
        *(u32x4*)(OG + ro + 8) = (u32x4){pk2(v2[0] * bflo(g1.x), v2[1] * bfhi(g1.x)), pk2(v2[2] * bflo(g1.y), v2[3] * bfhi(g1.y)), pk2(v3[0] * bflo(g1.z), v3[1] * bfhi(g1.z)), pk2(v3[2] * bflo(g1.w), v3[3] * bfhi(g1.w))};
    }
}

__device__ __forceinline__ void phase_final(const Params& p, int lane, int gw, int NGW) {
    const bf16_t* XB = (const bf16_t*)(p.ws + WS_XB); const float* nf = p.in[I_NORM_F];
    for (int rr = gw; rr < 8192 + 128; rr += NGW) {
        const int r = rr < 8192 ? rr : ROW_SAMP + (rr - 8192);
        float* dst = rr < 8192 ? p.out + O_YP + (size_t)rr * DM : p.out + O_YS + (size_t)(rr - 8192) * DM;
        u32x4 raw[4]; float ss = 0.f;
#pragma unroll
        for (int j = 0; j < 4; ++j) { raw[j] = __builtin_nontemporal_load((const u32x4*)(XB + (size_t)r * DM) + lane + 64 * j);
            const float a0 = bflo(raw[j].x), a1 = bfhi(raw[j].x), a2 = bflo(raw[j].y), a3 = bfhi(raw[j].y), a4 = bflo(raw[j].z), a5 = bfhi(raw[j].z), a6 = bflo(raw[j].w), a7 = bfhi(raw[j].w);
            ss += (a0 * a0 + a1 * a1) + (a2 * a2 + a3 * a3) + (a4 * a4 + a5 * a5) + (a6 * a6 + a7 * a7); }
        const float rinv = rsqrtf(wave_sum(ss) * (1.0f / DM) + EPS);
#pragma unroll
        for (int j = 0; j < 4; ++j) { const int c = 8 * (lane + 64 * j); const f32x4 g0 = *(const f32x4*)(nf + c), g1 = *(const f32x4*)(nf + c + 4);
            *(f32x4*)(dst + c) = (f32x4){bflo(raw[j].x), bfhi(raw[j].x), bflo(raw[j].y), bfhi(raw[j].y)} * rinv * g0;
            *(f32x4*)(dst + c + 4) = (f32x4){bflo(raw[j].z), bfhi(raw[j].z), bflo(raw[j].w), bfhi(raw[j].w)} * rinv * g1; }
    }
}

#define XB_TMO      128
#define XB_XCNT(j)  (256  + 64 * (j))
#define XB_XSUB(j)  (1280 + 64 * (j))
#define XB_XGEN(j)  (2304 + 64 * (j))
#define XB_TOP      3328
#define XB_TOPGEN   3392
#define XCD_BAR_WORDS 3456
#define XB_SPIN_CAP (1u << 18)

__device__ __forceinline__ unsigned xb_ld(unsigned* p)              { return __hip_atomic_load(p, __ATOMIC_RELAXED, __HIP_MEMORY_SCOPE_AGENT); }
__device__ __forceinline__ unsigned xb_add(unsigned* p, unsigned v) { return __hip_atomic_fetch_add(p, v, __ATOMIC_RELAXED, __HIP_MEMORY_SCOPE_AGENT); }
__device__ __forceinline__ unsigned xb_xcc_id() { return (unsigned)__builtin_amdgcn_s_getreg((3 << 11) | 20) & 0xFu; }
#define XB_SPIN(cond, bar) do { unsigned _sp = 0; while (cond) { __builtin_amdgcn_s_sleep(1); \
    if ((++_sp & 255u) == 0u) { if (xb_ld(&(bar)[XB_TMO])) break; if (_sp > XB_SPIN_CAP) { atomicAdd(&(bar)[XB_TMO], 1u); break; } } } } while (0)

struct XcdBarrier {
    unsigned* bar; unsigned x;
    volatile LAS unsigned* st;
};

__device__ __forceinline__ XcdBarrier xcd_barrier_post(unsigned* bar, volatile LAS unsigned* st) {
    XcdBarrier b; b.bar = bar; b.x = xb_xcc_id(); b.st = st;
    if (threadIdx.x == 0) (void)xb_add(&bar[XB_XCNT(b.x)], 1u);
    return b;
}
__device__ __forceinline__ void xcd_barrier_complete(unsigned* bar, unsigned x, unsigned& nloc, unsigned& nx) {
    const unsigned G = gridDim.x * gridDim.y * gridDim.z;
    unsigned sum, cnt, mine, sp = 0u;
    for (;;) {
        sum = 0u; cnt = 0u; mine = 0u;
#pragma unroll
        for (unsigned j = 0; j < 16; ++j) { const unsigned c = xb_ld(&bar[XB_XCNT(j)]); sum += c; cnt += (c > 0u) ? 1u : 0u; mine = (j == x) ? c : mine; }
        if (sum == G) break;
        __builtin_amdgcn_s_sleep(1);
        if ((++sp & 255u) == 0u) { if (xb_ld(&bar[XB_TMO])) break; if (sp > XB_SPIN_CAP) { atomicAdd(&bar[XB_TMO], 1u); break; } }
    }
    nloc = mine > 0u ? mine : 1u; nx = cnt > 0u ? cnt : 1u;
}

__device__ __forceinline__ void xcd_barrier(const XcdBarrier& b) {
    asm volatile("s_waitcnt vmcnt(0)" ::: "memory");
    __syncthreads();
    if (threadIdx.x == 0) {
        unsigned* bar = b.bar;
        __builtin_amdgcn_s_waitcnt(0);
        unsigned nloc = b.st[0], nx = b.st[1];
        if (nloc == 0u) { xcd_barrier_complete(bar, b.x, nloc, nx); b.st[0] = nloc; b.st[1] = nx; }
        const unsigned old = xb_add(&bar[XB_XSUB(b.x)], 1u);
        const unsigned gen = old / nloc;
        if (old + 1u == (gen + 1u) * nloc) {
            __builtin_amdgcn_fence(__ATOMIC_RELEASE, "agent");
            asm volatile("s_waitcnt vmcnt(0)" ::: "memory");
            const unsigned og = xb_add(&bar[XB_TOP], 1u);
            const unsigned tg = og / nx;
            if (og + 1u == (tg + 1u) * nx) xb_add(&bar[XB_TOPGEN], 1u);
            else XB_SPIN(xb_ld(&bar[XB_TOPGEN]) == tg, bar);
            __builtin_amdgcn_fence(__ATOMIC_ACQUIRE, "agent");
            xb_add(&bar[XB_XGEN(b.x)], 1u);
            asm volatile("s_waitcnt vmcnt(0)" ::: "memory");
        } else {
            XB_SPIN(xb_ld(&bar[XB_XGEN(b.x)]) == gen, bar);
            __builtin_amdgcn_fence(__ATOMIC_ACQUIRE, "agent");
            asm volatile("s_waitcnt vmcnt(0)" ::: "memory");
        }
    }
    __syncthreads();
}


constexpr int NPHASE = 18;
#ifndef DUP_MASK
#define DUP_MASK 0
#endif
#define REP(bit) for (int rep_ = 0; rep_ < 1 + ((DUP_MASK >> (bit)) & 1); ++rep_)
__device__ __forceinline__ int launder_i(int x) { asm volatile("" : "+v"(x)); return x; }
template <class T> __device__ __forceinline__ T* launder_p(T* x) { size_t z = 0; asm volatile("" : "+s"(z)); return (T*)((char*)x + z); }
__global__ void __launch_bounds__(NTHR, 2) yoco_fwd(Params p) {
    extern __shared__ __attribute__((aligned(16))) unsigned char lds_raw[];
    LAS unsigned char* lds = (LAS unsigned char*)lds_raw;
    cg::grid_group grid = cg::this_grid();
    if (threadIdx.x < 4) ((volatile LAS unsigned*)(lds + LDS_BYTES - 16))[threadIdx.x] = 0u;
    __syncthreads();
    XcdBarrier xbar = xcd_barrier_post((unsigned*)(p.ws + WS_CTL), (volatile LAS unsigned*)(lds + LDS_BYTES - 16));
    const int bid = blockIdx.x, G = gridDim.x;
    const int lo = p.ph_lo, hi = p.ph_hi;
#define IN(k) (lo <= (k) && (k) < hi)
#define SEAM(k) do { if (IN(k) && IN((k) + 1)) { xcd_barrier(xbar); if (DUP_MASK & 512) { xcd_barrier(xbar); xcd_barrier(xbar); } } } while (0)
#define PHASE_VIEW() const int tid = launder_i(threadIdx.x); const int lane = tid & 63; const int wave = __builtin_amdgcn_readfirstlane(tid >> 6); (void)lane; (void)wave; \
    unsigned char* ws = launder_p(p.ws); float* X = (float*)(ws + WS_X); bf16_t* XB = (bf16_t*)(ws + WS_XB); float* SSQ = (float*)(ws + WS_SSQ); float* GLR = (float*)(ws + WS_GLR); \
    bf16_t* R1 = (bf16_t*)(ws + WS_R1); bf16_t* R2 = (bf16_t*)(ws + WS_R2); bf16_t* SG = (bf16_t*)(ws + WS_SG); bf16_t* OG = (bf16_t*)(ws + WS_OG); \
    bf16_t* QA = R1; bf16_t* KA = R1 + (size_t)MP * 1024; bf16_t* VA = R2; bf16_t* KVB = R1; bf16_t* QB = R2; \
    float* DEC = (float*)(ws + WS_DEC); bf16_t* DSM = (bf16_t*)(ws + WS_DSM); float* ORAW = (float*)(ws + WS_ORAW); bf16_t* DS = (bf16_t*)(ws + WS_DS); \
    (void)X; (void)XB; (void)SSQ; (void)GLR; (void)SG; (void)OG; (void)QA; (void)KA; (void)VA; (void)KVB; (void)QB; (void)DEC; (void)DSM; (void)ORAW; (void)DS;

    if (IN(0)) REP(0) { PHASE_VIEW(); phase_p0(p, lds, tid, lane, wave, bid, G); }
    SEAM(0);
#pragma unroll 1
    for (int l = 0; l < 2; ++l) {
        const int pb = 1 + 5 * l;
        if (IN(pb)) REP(1) { PHASE_VIEW();
            const bf16_t* wt = (const bf16_t*)(ws + WS_WTA_IN + l * WTA_IN_SZ);
            pg8::Gemm g{XB, wt, 8192, 6144, DM}; pg8::StaticOrder S; S.init(8192, 6144, G, bid);
            pg8::EpiGlaIn E{SSQ, QA, KA, VA, SG, GLR};
            pg8::gemm_phase<pg8::EpiGlaIn, pg8::StaticOrder, true, true>(lds, g, S, E);
#pragma unroll 1
            for (int u = G - 1 - bid; u < 2 * 97; u += G) tail_gemm_unit(lds, launder_i(threadIdx.x), XB, wt, 64 * (u >> 1), u & 1, E);
#pragma unroll 1
            for (int u = bid; u < 256; u += G) glr_unit(lds, launder_i(threadIdx.x), XB, wt, u, SSQ, GLR);
            { const int t2 = launder_i(threadIdx.x); slot_convert(p, lds, CV_OA + l * CV_SQ, CV_SQ, G > 194 ? G - 194 : 0, t2 & 63, __builtin_amdgcn_readfirstlane(t2 >> 6), bid); }
        }
        SEAM(pb);
        if (IN(pb + 1)) REP(2) { PHASE_VIEW();
            const float* wg = p.in[I_WGK2] + (size_t)l * 16 * 1024; const float* bg = p.in[I_BGK2] + (size_t)l * 1024;
            { const float* onorm_s = p.in[I_ONORM] + (size_t)l * 512; const int half = G / 2 > 0 ? G / 2 : 1;
#pragma unroll 1
              for (int u = bid - (G - half); u < 128; u += half) { if (u < 0) break; const int tid = launder_i(threadIdx.x); const int bs = u >> 2, hh = u & 3; const size_t so = ((size_t)((l * 32 + bs) * 4 + hh) * 256) * 512;
                  gla_tile_sample_full(lds, tid, bs, hh, GLR, wg, bg, QA, KA, VA, p.in[I_SGLA] + so, p.out + O_SS + so, onorm_s, SG, OG); } }
#pragma unroll 1
            for (int t0 = bid; t0 < 512 + 4 + 4; t0 += G) { const int tid = launder_i(threadIdx.x); const int t = t0 + 256;
                if (t0 >= 516) gla_tile_c(lds, tid, ROW_META, 16, t0 - 516, GLR, wg, bg, QA, KA, VA, nullptr, p.in[I_ONORM] + (size_t)l * 512, SG, OG);
                else { int row0, ntok, h; bf16_t* dso; float* deco;
                    if (t < 768) { const int u = t - 256, b = u >> 8, c = (u >> 2) & 63; h = u & 3; row0 = b * 4096 + c * 64; ntok = 64;
                        dso = DS + ((size_t)((b * 64 + c) * 4 + h) * 512) * 256; deco = DEC + (size_t)((b * 64 + c) * 4 + h) * 256; }
                    else { h = t - 768; row0 = ROW_META; ntok = 16; dso = DSM + (size_t)h * 512 * 256; deco = nullptr; }
                    REP(11) gla_tile_a(lds, tid, row0, ntok, h, GLR, wg, bg, KA, VA, dso, deco); }
            }
        }
        SEAM(pb + 1);
        if (IN(pb + 2)) { PHASE_VIEW(); gla_scan(lds, tid, bid, G, DS, DSM, DEC, p.out + O_SP + (size_t)l * 2 * 4 * 256 * 512); }
        SEAM(pb + 2);
        if (IN(pb + 3)) REP(4) { PHASE_VIEW();
            const float* wg = p.in[I_WGK2] + (size_t)l * 16 * 1024; const float* bg = p.in[I_BGK2] + (size_t)l * 1024; const float* onorm = p.in[I_ONORM] + (size_t)l * 512;
#pragma unroll 1
            for (int t = bid; t < 512; t += G) { const int tid = launder_i(threadIdx.x);
                { const int b = t >> 8, c = (t >> 2) & 63, h = t & 3;
                    gla_tile_c(lds, tid, b * 4096 + c * 64, 64, h, GLR, wg, bg, QA, KA, VA, DS + ((size_t)((b * 64 + c) * 4 + h) * 512) * 256, onorm, SG, OG); }

            }
        }
        SEAM(pb + 3);
        if (IN(pb + 4)) { PHASE_VIEW();
            const bf16_t* wt = (const bf16_t*)(ws + WS_WTA_OUT + l * WT_SQ_SZ);
            pg8::Gemm g{OG, wt, 8192, DM, DM}; pg8::StaticOrder S; S.init(8192, DM, G, bid);
            pg8::EpiOut E{X, XB, SSQ};
            pg8::gemm_phase<pg8::EpiOut, pg8::StaticOrder, true, true>(lds, g, S, E);
#pragma unroll 1
            for (int u = G - 1 - bid; u < 64; u += G) tail_gemm_unit(lds, launder_i(threadIdx.x), OG, wt, 64 * (u >> 1), u & 1, E);
            { const int t2 = launder_i(threadIdx.x); const int ln2 = t2 & 63, wv2 = __builtin_amdgcn_readfirstlane(t2 >> 6);
              slot_convert(p, lds, l == 0 ? CV_INA : CV_OB0, l == 0 ? CV_INA : CV_SQ + CV_KV + CV_INB, G > 194 ? G - 64 : 0, ln2, wv2, bid);
              if (l == 0 && G > 194 && bid < G - 64) cache_copy(p, bid * NTHR + t2, (G - 64) * NTHR); }
        }
        SEAM(pb + 4);
    }
#pragma unroll 1
    for (int j = 0; j < 2; ++j) {
        const int pb = 11 + 3 * j;
        if (IN(pb)) REP(6) { PHASE_VIEW(); const int kvt = j == 0 ? 4 : 0; const int N = j == 0 ? 5120 : 4096;
            const bf16_t* wt = (const bf16_t*)(ws + (j == 0 ? WS_WTB0 : WS_WTB1));
            pg8::Gemm g{XB, wt, 8192, N, DM}; pg8::StaticOrder S; S.init(8192, N, G, bid);
            pg8::EpiSwaIn E{SSQ, KVB, QB, SG, p.out, kvt};
            pg8::gemm_phase<pg8::EpiSwaIn, pg8::StaticOrder, true, true>(lds, g, S, E);
#pragma unroll 1
            for (int u = (j == 0 ? (bid >= G / 2 ? G - 1 - bid : 1 << 20) : G - 1 - bid); u < N / 32; u += (j == 0 ? G / 2 : G)) tail_gemm_unit(lds, launder_i(threadIdx.x), XB, wt, 64 * (u >> 1), u & 1, E);
            if (j == 1) { const int t2 = launder_i(threadIdx.x); slot_convert(p, lds, CV_OB1, CV_SQ, G > 194 ? G - 128 : 0, t2 & 63, __builtin_amdgcn_readfirstlane(t2 >> 6), bid); }
        }
        SEAM(pb);
        if (IN(pb + 1)) REP(7) { PHASE_VIEW(); const float* sinks = p.in[I_SINKS] + j * 32;
#pragma unroll 1
            for (int t = bid; t < 256 + 512 + 8; t += G) { const int tid = launder_i(threadIdx.x);
                if (t < 256) REP(12) swa_decode_tile(lds, tid, t >> 3, t & 7, p.in[I_CK], p.in[I_CV], KVB, QB, SG, sinks, OG);
                else { int b, tq0, kvh, nq;
                    if (t < 768) { const int u = t - 256; b = u >> 8; tq0 = 128 * ((u >> 3) & 31); kvh = u & 7; nq = 128; }
                    else { b = 0; tq0 = -16; kvh = t - 768; nq = 16; }
                    REP(13) swa_tile(lds, tid, b, tq0, kvh, nq, KVB, QB, SG, sinks, OG); }
            }
        }
        SEAM(pb + 1);
        if (IN(pb + 2)) { PHASE_VIEW();
            const bf16_t* wt = (const bf16_t*)(ws + WS_WTB_OUT + j * WT_SQ_SZ);
            pg8::Gemm g{OG, wt, 8192, DM, DM}; pg8::StaticOrder S; S.init(8192, DM, G, bid);
            pg8::EpiOut E{X, XB, SSQ};
            pg8::gemm_phase<pg8::EpiOut, pg8::StaticOrder, true, true>(lds, g, S, E);
#pragma unroll 1
            for (int u = G - 1 - bid; u < 64; u += G) tail_gemm_unit(lds, launder_i(threadIdx.x), OG, wt, 64 * (u >> 1), u & 1, E);
            if (j == 0) { const int t2 = launder_i(threadIdx.x); slot_convert(p, lds, CV_IB1, CV_INB, G > 194 ? G - 64 : 0, t2 & 63, __builtin_amdgcn_readfirstlane(t2 >> 6), bid); }
        }
        SEAM(pb + 2);
    }
    if (IN(17)) REP(8) { PHASE_VIEW(); phase_final(p, lane, bid * 8 + wave, G * 8); }
    if (hi == -12345) grid.sync();
#undef IN
#undef SEAM
#undef PHASE_VIEW
}

#ifndef N_LAUNCH_MODE
#define N_LAUNCH_MODE 1
#endif
extern "C" void kernel_launch(void* const* d_in, const int* in_sizes, int n_in, void* d_out, int out_size, void* d_ws, size_t ws_size, hipStream_t stream) {
    static int grid = 0;
    if (grid == 0) {
        if (n_in != 19 || ws_size < WS_END) { fprintf(stderr, "kernel_launch: unexpected inputs (n_in %d, ws %zu < %zu)\n", n_in, ws_size, (size_t)WS_END); grid = -1; return; }
        int dev = 0, cus = 0, per_cu = 0;
        (void)hipGetDevice(&dev); (void)hipDeviceGetAttribute(&cus, hipDeviceAttributeMultiprocessorCount, dev);
        if (hipFuncSetAttribute((const void*)yoco_fwd, hipFuncAttributeMaxDynamicSharedMemorySize, LDS_BYTES) != hipSuccess) { fprintf(stderr, "kernel_launch: hipFuncSetAttribute failed\n"); grid = -1; return; }
        if (hipOccupancyMaxActiveBlocksPerMultiprocessor(&per_cu, (const void*)yoco_fwd, NTHR, LDS_BYTES) != hipSuccess || per_cu < 1) { fprintf(stderr, "kernel_launch: occupancy query says %d\n", per_cu); per_cu = 1; }
        (void)hipGetLastError();
        grid = cus > 0 ? cus : 256;
    }
    if (grid < 0) return;
    if (hipMemsetAsync((char*)d_ws + WS_CTL, 0, CTL_BYTES, stream) != hipSuccess) { fprintf(stderr, "kernel_launch: memset failed\n"); return; }
    Params p{};
    for (int i = 0; i < 19; ++i) p.in[i] = (const float*)d_in[i];
    p.out = (float*)d_out; p.ws = (unsigned char*)d_ws;
#if N_LAUNCH_MODE == 1
    p.ph_lo = 0; p.ph_hi = NPHASE;
    void* args[] = {&p};
    hipError_t e = hipLaunchCooperativeKernel((const void*)yoco_fwd, dim3(grid), dim3(NTHR), args, LDS_BYTES, stream);
    if (e != hipSuccess) fprintf(stderr, "cooperative launch failed: %s (grid %d)\n", hipGetErrorString(e), grid);
#else
    for (int ph = 0; ph < NPHASE; ++ph) { p.ph_lo = ph; p.ph_hi = ph + 1; hipLaunchKernelGGL(yoco_fwd, dim3(grid), dim3(NTHR), LDS_BYTES, stream, p); }
#endif
}
```
